# Optimizing an MI355X kernel written in HIP

```python
import math
import jax, jax.numpy as jnp
from jax import lax
import numpy as np

D_MODEL = 1024
BATCH = 2
SEQ = 16384
DEPTH = 2

MIX_WIDTH = D_MODEL
A_WIDTH = MIX_WIDTH // 2
B_WIDTH = MIX_WIDTH - A_WIDTH
C_WIDTH = MIX_WIDTH // 2
D_WIDTH = MIX_WIDTH - C_WIDTH
EVEN_IN_WIDTH = A_WIDTH + 3 * B_WIDTH
ODD_IN_WIDTH = 2 * C_WIDTH + 3 * D_WIDTH
S5_GROUP = 16
S5_GROUPS = A_WIDTH // S5_GROUP
S5_STATE = 64
DT_MIN = 1e-3
DT_MAX = 1e-1
CONV_WIDTH = 3
GMLP_CHUNK = 128
GMLP_HEADS = 8
GMLP_HEAD_DIM = C_WIDTH // GMLP_HEADS
SB_HEADS = 8
SB_HEAD_DIM = D_WIDTH // SB_HEADS
SB_BLOCK = 128
PEER_HEADS = 8
PEER_N_KEYS = 128
PEER_N_EXPERTS = PEER_N_KEYS ** 2
PEER_TOPK = 16
PEER_QUERY_DIM = 256
PEER_HALF = PEER_QUERY_DIM // 2
PEER_TOKEN_BLOCK = 128
RMS_EPS = 1e-6

kernel_name = "hybrid_s5_shortconv_gmlp_stickbreak_peer"


def rmsnorm(x, g):
    xf = x.astype(jnp.float32)
    y = xf * lax.rsqrt(jnp.mean(xf * xf, axis=-1, keepdims=True) + RMS_EPS)
    return (y * g.astype(jnp.float32)).astype(x.dtype)


def _complex_affine_combine(e1, e2):
    a1r, a1i, b1r, b1i = e1
    a2r, a2i, b2r, b2i = e2
    ar = a2r * a1r - a2i * a1i
    ai = a2r * a1i + a2i * a1r
    br = a2r * b1r - a2i * b1i + b2r
    bi = a2r * b1i + a2i * b1r + b2i
    return (ar, ai, br, bi)


def s5_mixer(u, lam_re, lam_im, log_dt, b_re, b_im, c_re, c_im, d_skip, glu_w, glu_b):
    bsz, seqlen, _ = u.shape
    dt = jnp.exp(log_dt.astype(jnp.float32))[:, None]
    lr = lam_re.astype(jnp.float32)
    li = lam_im.astype(jnp.float32)
    mag = jnp.exp(lr * dt)
    ar = mag * jnp.cos(li * dt)
    ai = mag * jnp.sin(li * dt)
    den = lr * lr + li * li
    nr = ar - 1.0
    fr = (nr * lr + ai * li) / den
    fi = (ai * lr - nr * li) / den
    bre = b_re.astype(jnp.float32)
    bim = b_im.astype(jnp.float32)
    bbar_re = fr[..., None] * bre - fi[..., None] * bim
    bbar_im = fr[..., None] * bim + fi[..., None] * bre
    uf = u.astype(jnp.float32).reshape(bsz, seqlen, S5_GROUPS, S5_GROUP)
    bu_re = jnp.einsum('gpc,blgc->blgp', bbar_re, uf)
    bu_im = jnp.einsum('gpc,blgc->blgp', bbar_im, uf)
    a_re = jnp.broadcast_to(ar, bu_re.shape)
    a_im = jnp.broadcast_to(ai, bu_im.shape)
    _, _, h_re, h_im = lax.associative_scan(_complex_affine_combine, (a_re, a_im, bu_re, bu_im), axis=1)
    y = (jnp.einsum('gcp,blgp->blgc', c_re.astype(jnp.float32), h_re)
         - jnp.einsum('gcp,blgp->blgc', c_im.astype(jnp.float32), h_im)
         + d_skip.astype(jnp.float32) * uf)
    y = jax.nn.gelu(y.reshape(bsz, seqlen, A_WIDTH))
    out = y * jax.nn.sigmoid(y @ glu_w.astype(jnp.float32) + glu_b.astype(jnp.float32))
    return out.astype(u.dtype)


def short_conv_mixer(b_gate, c_gate, x_in, conv_w):
    z = c_gate * x_in
    w = conv_w.astype(z.dtype)[:, None, :]
    conv = lax.conv_general_dilated(z, w, window_strides=(1,), padding=[(CONV_WIDTH - 1, 0)],
                                    dimension_numbers=('NWC', 'WIO', 'NWC'),
                                    feature_group_count=B_WIDTH)
    return b_gate * conv


def gmlp_mixer(u, v, vnorm_g, ws, bs):
    bsz, seqlen, _ = v.shape
    u = jax.nn.gelu(u)
    v = rmsnorm(jax.nn.gelu(v), vnorm_g)
    vc = v.reshape(bsz, seqlen // GMLP_CHUNK, GMLP_CHUNK, GMLP_HEADS, GMLP_HEAD_DIM)
    tril = jnp.tril(jnp.ones((GMLP_CHUNK, GMLP_CHUNK), dtype=bool))
    wm = jnp.where(tril, ws, jnp.zeros_like(ws))
    y = jnp.einsum('hts,bnshd->bnthd', wm, vc) + bs.T[None, None, :, :, None]
    return u * y.reshape(bsz, seqlen, C_WIDTH)


def stick_breaking_attention(q, k, v):
    bsz, seqlen, _ = q.shape
    nblk = seqlen // SB_BLOCK
    qf = q.astype(jnp.float32).reshape(bsz, seqlen, SB_HEADS, SB_HEAD_DIM) * (SB_HEAD_DIM ** -0.5)
    qb = qf.reshape(bsz, nblk, SB_BLOCK, SB_HEADS, SB_HEAD_DIM).transpose(1, 0, 3, 2, 4)
    kf = k.astype(jnp.float32).reshape(bsz, seqlen, SB_HEADS, SB_HEAD_DIM)
    vf = v.astype(jnp.float32).reshape(bsz, seqlen, SB_HEADS, SB_HEAD_DIM)
    key_pos = jnp.arange(seqlen)

    def block(args):
        q_blk, bidx = args
        q_pos = bidx * SB_BLOCK + jnp.arange(SB_BLOCK)
        z = jnp.einsum('bhqd,bkhd->bhqk', q_blk, kf)
        mask = key_pos[None, :] < q_pos[:, None]
        log_1mb = jnp.where(mask, jax.nn.log_sigmoid(-z), 0.0)
        rest = lax.cumsum(log_1mb, axis=3, reverse=True) - log_1mb
        w = jnp.where(mask, jnp.exp(jax.nn.log_sigmoid(z) + rest), 0.0)
        return jnp.einsum('bhqk,bkhd->bqhd', w, vf)

    o = lax.map(block, (qb, jnp.arange(nblk)))
    o = o.transpose(1, 0, 2, 3, 4).reshape(bsz, seqlen, D_WIDTH)
    return o.astype(q.dtype)


def peer_ffn(h, wq, k1, k2, u_tab, v_tab):
    bsz, seqlen, dm = h.shape
    hb = h.reshape(-1, PEER_TOKEN_BLOCK, dm)
    k1f = k1.astype(jnp.float32)
    k2f = k2.astype(jnp.float32)

    def block(hx):
        q = (hx @ wq).astype(jnp.float32).reshape(PEER_TOKEN_BLOCK, PEER_HEADS, 2, PEER_HALF)
        s1 = jnp.einsum('thd,hnd->thn', q[:, :, 0], k1f)
        s2 = jnp.einsum('thd,hnd->thn', q[:, :, 1], k2f)
        v1, i1 = lax.top_k(s1, PEER_TOPK)
        v2, i2 = lax.top_k(s2, PEER_TOPK)
        cand_s = (v1[..., :, None] + v2[..., None, :]).reshape(PEER_TOKEN_BLOCK, PEER_HEADS, PEER_TOPK * PEER_TOPK)
        cand_i = (i1[..., :, None] * PEER_N_KEYS + i2[..., None, :]).reshape(PEER_TOKEN_BLOCK, PEER_HEADS, PEER_TOPK * PEER_TOPK)
        top_s, pos = lax.top_k(cand_s, PEER_TOPK)
        idx = jnp.take_along_axis(cand_i, pos, axis=-1)
        g = jax.nn.softmax(top_s, axis=-1)
        u_sel = u_tab[idx]
        act = jax.nn.gelu(jnp.einsum('thkd,td->thk', u_sel, hx).astype(jnp.float32))
        v_sel = v_tab[idx]
        return jnp.einsum('thk,thkd->td', (g * act).astype(v_sel.dtype), v_sel).astype(hx.dtype)

    return lax.map(block, hb).reshape(bsz, seqlen, dm)


def even_mixer(h, w_in, lam_re, lam_im, log_dt, b_re, b_im, c_re, c_im, d_skip, glu_w, glu_b, conv_w, w_out):
    p = h @ w_in
    a_u = p[..., :A_WIDTH]
    b_b = p[..., A_WIDTH:A_WIDTH + B_WIDTH]
    b_c = p[..., A_WIDTH + B_WIDTH:A_WIDTH + 2 * B_WIDTH]
    b_x = p[..., A_WIDTH + 2 * B_WIDTH:]
    ya = s5_mixer(a_u, lam_re, lam_im, log_dt, b_re, b_im, c_re, c_im, d_skip, glu_w, glu_b)
    yb = short_conv_mixer(b_b, b_c, b_x, conv_w)
    return jnp.concatenate([ya, yb], axis=-1) @ w_out


def odd_mixer(h, w_in, vnorm_g, ws, bs, w_out):
    p = h @ w_in
    c_u = p[..., :C_WIDTH]
    c_v = p[..., C_WIDTH:2 * C_WIDTH]
    o = 2 * C_WIDTH
    d_q = p[..., o:o + D_WIDTH]
    d_k = p[..., o + D_WIDTH:o + 2 * D_WIDTH]
    d_v = p[..., o + 2 * D_WIDTH:]
    yc = gmlp_mixer(c_u, c_v, vnorm_g, ws, bs)
    yd = stick_breaking_attention(d_q, d_k, d_v)
    return jnp.concatenate([yc, yd], axis=-1) @ w_out


def setup_inputs(seed: int = 0) -> dict:
    key = jax.random.key(seed)
    ks = iter(jax.random.split(key, 48))

    def nrm(shape, scale):
        return jax.random.normal(next(ks), shape, jnp.float32) * scale

    def gain(n):
        return 1.0 + nrm((n,), 0.02)

    def peer_params():
        return (nrm((D_MODEL, PEER_HEADS * PEER_QUERY_DIM), D_MODEL ** -0.5),
                nrm((PEER_HEADS, PEER_N_KEYS, PEER_HALF), PEER_HALF ** -0.5),
                nrm((PEER_HEADS, PEER_N_KEYS, PEER_HALF), PEER_HALF ** -0.5),
                nrm((PEER_N_EXPERTS, D_MODEL), D_MODEL ** -0.5),
                nrm((PEER_N_EXPERTS, D_MODEL), PEER_HEADS ** -0.5))

    x = nrm((BATCH, SEQ, D_MODEL), 1.0)
    l0_norm_mix_g = gain(D_MODEL)
    l0_w_in = nrm((D_MODEL, EVEN_IN_WIDTH), D_MODEL ** -0.5)
    a_lam_re = -0.5 + nrm((S5_GROUPS, S5_STATE), 0.01)
    a_lam_im = math.pi * jnp.arange(S5_STATE, dtype=jnp.float32)[None, :] + nrm((S5_GROUPS, S5_STATE), 0.01)
    a_log_dt = jax.random.uniform(next(ks), (S5_GROUPS,), jnp.float32, math.log(DT_MIN), math.log(DT_MAX))
    a_b_re = nrm((S5_GROUPS, S5_STATE, S5_GROUP), (2 * S5_GROUP) ** -0.5)
    a_b_im = nrm((S5_GROUPS, S5_STATE, S5_GROUP), (2 * S5_GROUP) ** -0.5)
    a_c_re = nrm((S5_GROUPS, S5_GROUP, S5_STATE), S5_STATE ** -0.5)
    a_c_im = nrm((S5_GROUPS, S5_GROUP, S5_STATE), S5_STATE ** -0.5)
    a_d = nrm((S5_GROUPS, S5_GROUP), 1.0)
    a_glu_w = nrm((A_WIDTH, A_WIDTH), A_WIDTH ** -0.5)
    a_glu_b = nrm((A_WIDTH,), 0.02)
    b_conv_w = nrm((CONV_WIDTH, B_WIDTH), CONV_WIDTH ** -0.5)
    l0_w_out = nrm((MIX_WIDTH, D_MODEL), MIX_WIDTH ** -0.5)
    l0_norm_ffn_g = gain(D_MODEL)
    l0_peer_wq, l0_peer_k1, l0_peer_k2, l0_peer_u, l0_peer_v = peer_params()
    l1_norm_mix_g = gain(D_MODEL)
    l1_w_in = nrm((D_MODEL, ODD_IN_WIDTH), D_MODEL ** -0.5)
    c_vnorm_g = gain(C_WIDTH)
    c_ws = nrm((GMLP_HEADS, GMLP_CHUNK, GMLP_CHUNK), 0.5 * GMLP_CHUNK ** -0.5)
    c_bs = 1.0 + nrm((GMLP_HEADS, GMLP_CHUNK), 0.1)
    l1_w_out = nrm((MIX_WIDTH, D_MODEL), MIX_WIDTH ** -0.5)
    l1_norm_ffn_g = gain(D_MODEL)
    l1_peer_wq, l1_peer_k1, l1_peer_k2, l1_peer_u, l1_peer_v = peer_params()
    final_norm_g = gain(D_MODEL)
    return {
        "x": x,
        "l0_norm_mix_g": l0_norm_mix_g, "l0_w_in": l0_w_in,
        "a_lam_re": a_lam_re, "a_lam_im": a_lam_im, "a_log_dt": a_log_dt,
        "a_b_re": a_b_re, "a_b_im": a_b_im, "a_c_re": a_c_re, "a_c_im": a_c_im, "a_d": a_d,
        "a_glu_w": a_glu_w, "a_glu_b": a_glu_b, "b_conv_w": b_conv_w, "l0_w_out": l0_w_out,
        "l0_norm_ffn_g": l0_norm_ffn_g, "l0_peer_wq": l0_peer_wq, "l0_peer_k1": l0_peer_k1,
        "l0_peer_k2": l0_peer_k2, "l0_peer_u": l0_peer_u, "l0_peer_v": l0_peer_v,
        "l1_norm_mix_g": l1_norm_mix_g, "l1_w_in": l1_w_in, "c_vnorm_g": c_vnorm_g,
        "c_ws": c_ws, "c_bs": c_bs, "l1_w_out": l1_w_out,
        "l1_norm_ffn_g": l1_norm_ffn_g, "l1_peer_wq": l1_peer_wq, "l1_peer_k1": l1_peer_k1,
        "l1_peer_k2": l1_peer_k2, "l1_peer_u": l1_peer_u, "l1_peer_v": l1_peer_v,
        "final_norm_g": final_norm_g,
    }


def reference(x, l0_norm_mix_g, l0_w_in, a_lam_re, a_lam_im, a_log_dt, a_b_re, a_b_im, a_c_re, a_c_im, a_d,
              a_glu_w, a_glu_b, b_conv_w, l0_w_out, l0_norm_ffn_g, l0_peer_wq, l0_peer_k1, l0_peer_k2,
              l0_peer_u, l0_peer_v, l1_norm_mix_g, l1_w_in, c_vnorm_g, c_ws, c_bs, l1_w_out, l1_norm_ffn_g,
              l1_peer_wq, l1_peer_k1, l1_peer_k2, l1_peer_u, l1_peer_v, final_norm_g):
    layers = (
        (l0_norm_mix_g, (l0_w_in, a_lam_re, a_lam_im, a_log_dt, a_b_re, a_b_im, a_c_re, a_c_im, a_d,
                         a_glu_w, a_glu_b, b_conv_w, l0_w_out),
         l0_norm_ffn_g, (l0_peer_wq, l0_peer_k1, l0_peer_k2, l0_peer_u, l0_peer_v)),
        (l1_norm_mix_g, (l1_w_in, c_vnorm_g, c_ws, c_bs, l1_w_out),
         l1_norm_ffn_g, (l1_peer_wq, l1_peer_k1, l1_peer_k2, l1_peer_u, l1_peer_v)),
    )
    h = x
    for layer in range(DEPTH):
        norm_mix_g, mix_params, norm_ffn_g, peer_params = layers[layer]
        hn = rmsnorm(h, norm_mix_g)
        if layer % 2 == 0:
            h = h + even_mixer(hn, *mix_params)
        else:
            h = h + odd_mixer(hn, *mix_params)
        h = h + peer_ffn(rmsnorm(h, norm_ffn_g), *peer_params)
    return rmsnorm(h, final_norm_g)
```

```cpp
#ifndef HOST_EMU
#include <hip/hip_runtime.h>
#include <hip/hip_cooperative_groups.h>
#include <cstdio>
#define DECL_SMEM(name, bytes) __shared__ __attribute__((aligned(16))) char name[bytes]
#define GRID_SYNC() cooperative_groups::this_grid().sync()
#define WAVE_SYNC() do { __builtin_amdgcn_fence(__ATOMIC_RELEASE, "wavefront"); __builtin_amdgcn_wave_barrier(); __builtin_amdgcn_fence(__ATOMIC_ACQUIRE, "wavefront"); } while (0)
#else
#define DECL_SMEM(name, bytes) char* name = emu::smem(bytes)
#define GRID_SYNC() emu_grid_sync()
#define WAVE_SYNC() emu::sync(emu::ST_WAVE)
#endif
#include <utility>
#define DEVFN __device__ __forceinline__
#ifndef HOST_EMU
#define OPAQUE(x) asm volatile("" : "+v"(x))
#else
#define OPAQUE(x) asm volatile("" : "+r"(x))
#endif

#ifndef CFG_DM
#define CFG_DM 1024
#define CFG_SEQ 16384
#define CFG_PH 8
#endif

typedef unsigned short bf16_t;
typedef short bf16x8 __attribute__((ext_vector_type(8)));
typedef float f32x16 __attribute__((ext_vector_type(16)));
typedef unsigned u32x4 __attribute__((ext_vector_type(4)));
typedef unsigned u32x2 __attribute__((ext_vector_type(2)));
typedef float f32x4 __attribute__((ext_vector_type(4)));

constexpr int DM = CFG_DM, SEQ = CFG_SEQ, NB = 2, T = NB * SEQ;
constexpr int AW = DM / 2;
constexpr int EVEN_IN = 4 * AW, ODD_IN = 5 * AW;
constexpr int NG = AW / 16, NST = 64;
constexpr int NH = AW / 64;
constexpr int PH = CFG_PH, QN = PH * 256;
constexpr int NKEY = 128, NEXP = NKEY * NKEY, TOPK = 16, NSEL = PH * TOPK;
constexpr int SQ = 64, NCH = SEQ / SQ;
constexpr float RMS_EPS = 1e-6f;

DEVFN float bf2f(bf16_t h) { return __builtin_bit_cast(float, (unsigned)h << 16); }
DEVFN bf16_t f2bf(float f) { unsigned u = __builtin_bit_cast(unsigned, f); u += 0x7fffu + ((u >> 16) & 1u); return (bf16_t)(u >> 16); }
DEVFN float bflo(unsigned w) { return __builtin_bit_cast(float, w << 16); }
DEVFN float bfhi(unsigned w) { return __builtin_bit_cast(float, w & 0xffff0000u); }
DEVFN unsigned pack2(float lo, float hi) { return (unsigned)f2bf(lo) | ((unsigned)f2bf(hi) << 16); }
DEVFN float sigmoid_f(float x) { return 1.0f / (1.0f + __expf(-x)); }
DEVFN float gelu_f(float x) { float u = 1.5957691216057308f * (x + 0.044715f * x * x * x); return x / (1.0f + __expf(-u)); }
DEVFN void swap32(float& a, float& b) {
#ifndef HOST_EMU
  asm volatile("v_nop\n\tv_nop\n\tv_permlane32_swap_b32 %0, %1" : "+v"(a), "+v"(b));
#else
  const int lane = emu::cur % 64; const float xa = __shfl(a, lane ^ 32), xb = __shfl(b, lane ^ 32);
  if (lane < 32) b = xa; else a = xb;
#endif
}
DEVFN void swap16(float& a, float& b) {
#ifndef HOST_EMU
  asm volatile("v_nop\n\tv_nop\n\tv_permlane16_swap_b32 %0, %1" : "+v"(a), "+v"(b));
#else
  const int lane = emu::cur % 64; const float xa = __shfl(a, lane ^ 16), xb = __shfl(b, lane ^ 16);
  if ((lane & 16) == 0) b = xa; else a = xb;
#endif
}
template <int CTRL> DEVFN float dpp_f(float v) {
#ifndef HOST_EMU
  return __builtin_bit_cast(float, __builtin_amdgcn_update_dpp(0, __builtin_bit_cast(int, v), CTRL, 0xf, 0xf, true));
#else
  const int lane = emu::cur % 64;
  const int srcl = CTRL == 0x128 ? (lane ^ 8) : CTRL == 0x141 ? ((lane & ~7) | (7 - (lane & 7))) : CTRL == 0xB1 ? (lane ^ 1) : (lane ^ 2);
  return __shfl(v, srcl);
#endif
}

DEVFN float partner32(float v) { float a = v, b = v; swap32(a, b); return (threadIdx.x & 32) ? a : b; }
DEVFN float row16_sum(float v) { v += dpp_f<0xB1>(v); v += dpp_f<0x4E>(v); v += dpp_f<0x141>(v); v += dpp_f<0x128>(v); return v; }
DEVFN float row16_max(float v) { v = fmaxf(v, dpp_f<0xB1>(v)); v = fmaxf(v, dpp_f<0x4E>(v)); v = fmaxf(v, dpp_f<0x141>(v)); v = fmaxf(v, dpp_f<0x128>(v)); return v; }
DEVFN float wave_sum(float v) {
  v += dpp_f<0xB1>(v); v += dpp_f<0x4E>(v); v += dpp_f<0x141>(v); v += dpp_f<0x128>(v);
  { float a = v, b = v; swap16(a, b); v += (threadIdx.x & 16) ? a : b; }
  { float a = v, b = v; swap32(a, b); v += (threadIdx.x & 32) ? a : b; }
  return v;
}
DEVFN f32x16 mfma32(bf16x8 a, bf16x8 b, f32x16 c) {
#ifndef HOST_EMU
  return __builtin_amdgcn_mfma_f32_32x32x16_bf16(a, b, c, 0, 0, 0);
#else
  return emu_mfma32x32x16(a, b, c);
#endif
}


typedef float f32x2 __attribute__((ext_vector_type(2)));
#ifdef HOST_EMU
static inline unsigned emu_f2e4m3(float x) {
  unsigned s = (x < 0.f || (x == 0.f && std::signbit(x))) ? 0x80u : 0u; float a = fabsf(x);
  if (!(a == a)) return s | 0x7f;
  if (a >= 464.f) return s | 0x7e;
  if (a < 0.0009765625f) return s;
  int e; float m = frexpf(a, &e); e -= 1; m *= 2.f;
  if (e < -6) { float q = a * 512.f; float r = nearbyintf(q); unsigned mi = (unsigned)r; return s | mi; }
  float q = (m - 1.f) * 8.f; float r = nearbyintf(q); unsigned mi = (unsigned)r;
  if (mi == 8) { mi = 0; e += 1; }
  unsigned code = ((unsigned)(e + 7) << 3) | mi; if (code > 0x7e) code = 0x7e;
  return s | code;
}
static inline float emu_e4m32f(unsigned c) {
  float sgn = (c & 0x80) ? -1.f : 1.f; unsigned E = (c >> 3) & 15, m = c & 7;
  float v = E == 0 ? (m / 8.f) * 0.015625f : (1.f + m / 8.f) * ldexpf(1.f, (int)E - 7);
  return sgn * v;
}
#endif
DEVFN unsigned pack_fp8x4(float a, float b, float c, float d) {
#ifndef HOST_EMU
  int w = 0;
  w = __builtin_amdgcn_cvt_pk_fp8_f32(a, b, w, false);
  w = __builtin_amdgcn_cvt_pk_fp8_f32(c, d, w, true);
  return (unsigned)w;
#else
  return emu_f2e4m3(a) | (emu_f2e4m3(b) << 8) | (emu_f2e4m3(c) << 16) | (emu_f2e4m3(d) << 24);
#endif
}
DEVFN f32x2 unpack_fp8_lo(unsigned w) {
#ifndef HOST_EMU
  return __builtin_amdgcn_cvt_pk_f32_fp8((int)w, false);
#else
  return f32x2{emu_e4m32f(w & 255), emu_e4m32f((w >> 8) & 255)};
#endif
}
DEVFN f32x2 unpack_fp8_hi(unsigned w) {
#ifndef HOST_EMU
  return __builtin_amdgcn_cvt_pk_f32_fp8((int)w, true);
#else
  return f32x2{emu_e4m32f((w >> 16) & 255), emu_e4m32f(w >> 24)};
#endif
}

DEVFN int sdot4(int a, int b, int c) {
#ifndef HOST_EMU
  return __builtin_amdgcn_sdot4(a, b, c, false);
#else
  for (int i = 0; i < 4; ++i) c += (int)(signed char)(a >> (8 * i)) * (int)(signed char)(b >> (8 * i));
  return c;
#endif
}
DEVFN int sdot8(int a, int b, int c) {
#ifndef HOST_EMU
  return __builtin_amdgcn_sdot8(a, b, c, false);
#else
  for (int i = 0; i < 8; ++i) c += ((a << (28 - 4 * i)) >> 28) * ((b << (28 - 4 * i)) >> 28);
  return c;
#endif
}
DEVFN unsigned pack_i8x4(float a, float b, float c, float d) {
  return ((unsigned)(int)rintf(a) & 255u) | (((unsigned)(int)rintf(b) & 255u) << 8) | (((unsigned)(int)rintf(c) & 255u) << 16) | (((unsigned)(int)rintf(d) & 255u) << 24);
}
#ifdef HOST_EMU
static inline unsigned emu_f2e2m1(float x) {
  unsigned s = (x < 0.f || (x == 0.f && std::signbit(x))) ? 8u : 0u; float a = fabsf(x);
  static const float grid[8] = {0.f, 0.5f, 1.f, 1.5f, 2.f, 3.f, 4.f, 6.f};
  unsigned best = 0; float bd = 1e30f;
  for (unsigned i = 0; i < 8; ++i) { float d = fabsf(a - grid[i]); if (d < bd || (d == bd && (i & 1) == 0)) { bd = d; best = i; } }
  return s | best;
}
static inline float emu_e2m12f(unsigned c) { static const float grid[8] = {0.f, 0.5f, 1.f, 1.5f, 2.f, 3.f, 4.f, 6.f}; return ((c & 8) ? -1.f : 1.f) * grid[c & 7]; }
#endif
DEVFN unsigned pack_fp4x8(const float (&x)[8]) {
#ifndef HOST_EMU
  unsigned w = 0;
  w = __builtin_amdgcn_cvt_scalef32_pk_fp4_f32(w, x[0], x[1], 1.0f, 0);
  w = __builtin_amdgcn_cvt_scalef32_pk_fp4_f32(w, x[2], x[3], 1.0f, 1);
  w = __builtin_amdgcn_cvt_scalef32_pk_fp4_f32(w, x[4], x[5], 1.0f, 2);
  w = __builtin_amdgcn_cvt_scalef32_pk_fp4_f32(w, x[6], x[7], 1.0f, 3);
  return w;
#else
  unsigned w = 0;
  for (int i = 0; i < 8; ++i) w |= emu_f2e2m1(x[i]) << (4 * i);
  return w;
#endif
}
template <int BYTE> DEVFN f32x2 unpack_fp4(unsigned w) {
#ifndef HOST_EMU
  return __builtin_amdgcn_cvt_scalef32_pk_f32_fp4(w, 1.0f, BYTE);
#else
  return f32x2{emu_e2m12f((w >> (8 * BYTE)) & 15), emu_e2m12f((w >> (8 * BYTE + 4)) & 15)};
#endif
}
DEVFN float bcast_lane(float v, int srclane) {
#ifndef HOST_EMU
  return __builtin_bit_cast(float, __builtin_amdgcn_readlane(__builtin_bit_cast(int, v), srclane));
#else
  return __shfl(v, srclane);
#endif
}
DEVFN int bcast_lane_i(int v, int srclane) {
#ifndef HOST_EMU
  return __builtin_amdgcn_readlane(v, srclane);
#else
  return __shfl(v, srclane);
#endif
}

DEVFN int opaque_tid() { int t = threadIdx.x; OPAQUE(t); return t; }
#define TIDX opaque_tid()

DEVFN unsigned long long wave_ballot(bool p) {
#ifndef HOST_EMU
  return __builtin_amdgcn_ballot_w64(p);
#else
  return __ballot(p ? 1 : 0);
#endif
}
DEVFN int mbcnt64(unsigned long long m, int lane) {
#ifndef HOST_EMU
  return (int)__builtin_amdgcn_mbcnt_hi((unsigned)(m >> 32), __builtin_amdgcn_mbcnt_lo((unsigned)m, 0u));
#else
  return __builtin_popcountll(m & ((1ull << lane) - 1ull));
#endif
}


constexpr int NT = 512, NWV = NT / 64;
constexpr int SMEM_BYTES = 160 * 1024;

struct S5Tab { float* ar; float* ai; float* aqr; float* aqi; float* a16r; float* a16i; bf16_t* bbT; bf16_t* cmP; };
struct Params {
  const float* in[34];
  float* hout;
  bf16_t* wt_in0; bf16_t* wt_glu; bf16_t* wt_out0; bf16_t* wt_q0; bf16_t* wt_in1; bf16_t* wt_out1; bf16_t* wt_q1;
  bf16_t* keys[4]; unsigned char* tabs[4]; float* tscale[4];
  bf16_t* hb; bf16_t* pb; bf16_t* cb; bf16_t* ya;
  int* idx; float* gate;
  float* S; float* S2; float* rinv; float* rinv2;
  S5Tab tb;
  unsigned* bar;
  bf16_t* wsb;
};

DEVFN void prep_wt(const float* __restrict__ W, const float* __restrict__ g, bf16_t* __restrict__ Wt, int K, int N, char* smem) {
  const int sub = TIDX >> 8, stid = TIDX & 255;
  float* tile = (float*)(smem + sub * (64 * 65 * 4));
  const int ntn = N / 64, ntiles = (K / 64) * ntn;
  const int stride = gridDim.x * 2;
  const int iters = (ntiles + stride - 1) / stride;
  for (int it = 0; it < iters; ++it) {
    const int vb = (it * gridDim.x + blockIdx.x) * 2 + sub;
    const bool act = vb < ntiles;
    const int k0 = (vb / ntn) * 64, n0 = (vb % ntn) * 64;
    __syncthreads();
    if (act)
      for (int e = stid; e < 64 * 64; e += 256) {
        int i = e >> 6, j = e & 63;
        float gv = g ? g[k0 + i] : 1.0f;
        tile[i * 65 + j] = W[(size_t)(k0 + i) * N + n0 + j] * gv;
      }
    __syncthreads();
    if (act)
      for (int e = stid; e < 64 * 64; e += 256) {
        int j = e >> 6, i = e & 63;
        Wt[(size_t)(n0 + j) * K + k0 + i] = f2bf(tile[i * 65 + j]);
      }
  }
}
DEVFN void cvt_bf16(const float* __restrict__ src, bf16_t* __restrict__ dst, size_t n4) {
  for (size_t i = (size_t)blockIdx.x * NT + TIDX; i < n4; i += (size_t)gridDim.x * NT) {
    f32x4 v = ((const f32x4*)src)[i];
    ((u32x2*)dst)[i] = u32x2{pack2(v.x, v.y), pack2(v.z, v.w)};
  }
}
constexpr int CMK = 144;
DEVFN void prep_s5(const Params& P) {
  for (int gid = blockIdx.x * NT + TIDX; gid < NG * NST; gid += gridDim.x * NT) {
  const int gp = gid, g = gid / NST, p = gid % NST;
  const float* lam_re = P.in[3]; const float* lam_im = P.in[4]; const float* log_dt = P.in[5];
  const float* b_re = P.in[6]; const float* b_im = P.in[7];
  const float* c_re = P.in[8]; const float* c_im = P.in[9]; const float* dsk = P.in[10];
  const S5Tab& tb = P.tb;
  const float dt = __expf(log_dt[g]);
  const float lr = lam_re[gp], li = lam_im[gp];
  const float mag = __expf(lr * dt);
  const float ar = mag * cosf(li * dt), ai = mag * sinf(li * dt);
  const float den = lr * lr + li * li;
  const float nr = ar - 1.0f;
  const float fr = (nr * lr + ai * li) / den, fi = (ai * lr - nr * li) / den;
  tb.ar[gp] = ar; tb.ai[gp] = ai;
  float qr = ar, qi = ai;
#pragma unroll
  for (int sq = 0; sq < 6; ++sq) {
    float nr2 = qr * qr - qi * qi, ni2 = 2.0f * qr * qi; qr = nr2; qi = ni2;
    if (sq == 3) { tb.a16r[gp] = qr; tb.a16i[gp] = qi; }
  }
  tb.aqr[gp] = qr; tb.aqi[gp] = qi;
  const int c = p & 31, hi = p >> 5;
  for (int ci = 0; ci < 16; ++ci) {
    const float br = b_re[gp * 16 + ci], bi = b_im[gp * 16 + ci];
    tb.bbT[((size_t)g * 128 + (0 + hi) * 32 + c) * 16 + ci] = f2bf(fr * br - fi * bi);
    tb.bbT[((size_t)g * 128 + (2 + hi) * 32 + c) * 16 + ci] = f2bf(fr * bi + fi * br);
  }
  for (int co = 0; co < 16; ++co) {
    tb.cmP[((size_t)g * 16 + co) * CMK + 4 * c + 2 * hi + 0] = f2bf(c_re[((size_t)g * 16 + co) * NST + p]);
    tb.cmP[((size_t)g * 16 + co) * CMK + 4 * c + 2 * hi + 1] = f2bf(-c_im[((size_t)g * 16 + co) * NST + p]);
    if (p < 16) tb.cmP[((size_t)g * 16 + co) * CMK + 128 + p] = (p == co) ? f2bf(dsk[g * 16 + co]) : (bf16_t)0;
  }
  }
}
DEVFN void rowstat(const float* __restrict__ h, float* __restrict__ rinv, bf16_t* __restrict__ hb) {
  const int lane = TIDX & 63;
  for (int t = blockIdx.x * NWV + (TIDX >> 6); t < T; t += gridDim.x * NWV) {
    const float* row = h + (size_t)t * DM;
    float ss = 0.f;
#pragma unroll
    for (int i = 0; i < DM / 256; ++i) {
      f32x4 v = ((const f32x4*)row)[i * 64 + lane];
      ss += v.x * v.x + v.y * v.y + v.z * v.z + v.w * v.w;
      if (hb) ((u32x2*)(hb + (size_t)t * DM))[i * 64 + lane] = u32x2{pack2(v.x, v.y), pack2(v.z, v.w)};
    }
    ss = wave_sum(ss);
    if (lane == 0) rinv[t] = rsqrtf(ss * (1.0f / DM) + RMS_EPS);
  }
}
DEVFN void rowstat_v(const bf16_t* __restrict__ pb, float* __restrict__ rinv_v) {
  const int lane = TIDX & 63;
  for (int t = blockIdx.x * NWV + (TIDX >> 6); t < T; t += gridDim.x * NWV) {
    const bf16_t* row = pb + (size_t)t * ODD_IN + AW;
    float ss = 0.f;
    for (int c = lane; c < AW; c += 64) { float v = gelu_f(bf2f(row[c])); ss += v * v; }
    ss = wave_sum(ss);
    if (lane == 0) rinv_v[t] = rsqrtf(ss * (1.0f / AW) + RMS_EPS);
  }
}
constexpr int EPL = DM / 64;
constexpr int EW = EPL / 4;
DEVFN void prep_tab_fp8(const float* __restrict__ src, unsigned char* __restrict__ dst, float* __restrict__ scale) {
  const int lane = TIDX & 63;
  for (int r = blockIdx.x * NWV + (TIDX >> 6); r < NEXP; r += gridDim.x * NWV) {
    float v[EPL];
#pragma unroll
    for (int k = 0; k < EW; ++k) { f32x4 x = *(const f32x4*)(src + (size_t)r * DM + lane * EPL + 4 * k); v[4 * k] = x.x; v[4 * k + 1] = x.y; v[4 * k + 2] = x.z; v[4 * k + 3] = x.w; }
    float mx = 0.f;
#pragma unroll
    for (int i = 0; i < EPL; ++i) mx = fmaxf(mx, fabsf(v[i]));
    mx = row16_max(mx);
    { float a = mx, b = mx; swap16(a, b); mx = fmaxf(mx, (threadIdx.x & 16) ? a : b); }
    mx = fmaxf(mx, partner32(mx));
    mx = fmaxf(mx, 1e-30f);
    const float inv = 224.0f / mx;
    unsigned w[EW];
#pragma unroll
    for (int k = 0; k < EW; ++k) w[k] = pack_fp8x4(v[4 * k] * inv, v[4 * k + 1] * inv, v[4 * k + 2] * inv, v[4 * k + 3] * inv);
    if constexpr (EW == 4) *(u32x4*)(dst + (size_t)r * DM + lane * EPL) = u32x4{w[0], w[1], w[2], w[3]};
    else *(u32x2*)(dst + (size_t)r * DM + lane * EPL) = u32x2{w[0], w[1]};
    if (lane == 0) scale[r] = mx * (1.0f / 224.0f);
  }
}
DEVFN void prep_tab_i8(const float* __restrict__ src, unsigned char* __restrict__ dst, float* __restrict__ scale) {
  const int lane = TIDX & 63;
  for (int r = blockIdx.x * NWV + (TIDX >> 6); r < NEXP; r += gridDim.x * NWV) {
    float v[EPL];
#pragma unroll
    for (int k = 0; k < EW; ++k) { f32x4 x = *(const f32x4*)(src + (size_t)r * DM + lane * EPL + 4 * k); v[4 * k] = x.x; v[4 * k + 1] = x.y; v[4 * k + 2] = x.z; v[4 * k + 3] = x.w; }
    float mx = 0.f;
#pragma unroll
    for (int i = 0; i < EPL; ++i) mx = fmaxf(mx, fabsf(v[i]));
    mx = row16_max(mx);
    { float a = mx, b = mx; swap16(a, b); mx = fmaxf(mx, (threadIdx.x & 16) ? a : b); }
    mx = fmaxf(mx, partner32(mx));
    mx = fmaxf(mx, 1e-30f);
    const float inv = 127.0f / mx;
    unsigned w[EW];
#pragma unroll
    for (int k = 0; k < EW; ++k) w[k] = pack_i8x4(v[4 * k] * inv, v[4 * k + 1] * inv, v[4 * k + 2] * inv, v[4 * k + 3] * inv);
    if constexpr (EW == 4) *(u32x4*)(dst + (size_t)r * DM + lane * EPL) = u32x4{w[0], w[1], w[2], w[3]};
    else *(u32x2*)(dst + (size_t)r * DM + lane * EPL) = u32x2{w[0], w[1]};
    if (lane == 0) scale[r] = mx * (1.0f / 127.0f);
  }
}
constexpr int U4W = EW / 2;
static_assert(EW % 2 == 0, "int4 u rows need EPL to be a multiple of 8");
DEVFN void prep_tab_i4(const float* __restrict__ src, unsigned char* __restrict__ dst, float* __restrict__ scale) {
  const int lane = TIDX & 63;
  for (int r = blockIdx.x * NWV + (TIDX >> 6); r < NEXP; r += gridDim.x * NWV) {
    float v[EPL];
#pragma unroll
    for (int k = 0; k < EW; ++k) { f32x4 x = *(const f32x4*)(src + (size_t)r * DM + lane * EPL + 4 * k); v[4 * k] = x.x; v[4 * k + 1] = x.y; v[4 * k + 2] = x.z; v[4 * k + 3] = x.w; }
    float mx = 0.f;
#pragma unroll
    for (int i = 0; i < EPL; ++i) mx = fmaxf(mx, fabsf(v[i]));
    mx = row16_max(mx);
    { float a = mx, b = mx; swap16(a, b); mx = fmaxf(mx, (threadIdx.x & 16) ? a : b); }
    mx = fmaxf(mx, partner32(mx));
    mx = fmaxf(mx, 1e-30f);
    const float inv = 7.0f / mx;
    unsigned w[U4W];
#pragma unroll
    for (int g = 0; g < U4W; ++g) {
      w[g] = 0u;
#pragma unroll
      for (int k = 0; k < 8; ++k) w[g] |= ((unsigned)(int)rintf(v[8 * g + k] * inv) & 15u) << (4 * k);
    }
    if constexpr (U4W == 2) *(u32x2*)(dst + (size_t)r * DM + lane * EPL) = u32x2{w[0], w[1]};
    else *(unsigned*)(dst + (size_t)r * DM + lane * EPL) = w[0];
    if (lane == 0) scale[r] = mx * (1.0f / 7.0f);
  }
}
DEVFN void prep_tab_fp4(const float* __restrict__ src, unsigned char* __restrict__ dst, float* __restrict__ scale) {
  const int lane = TIDX & 63;
  for (int r = blockIdx.x * NWV + (TIDX >> 6); r < NEXP; r += gridDim.x * NWV) {
    float v[EPL];
#pragma unroll
    for (int k = 0; k < EW; ++k) { f32x4 x = *(const f32x4*)(src + (size_t)r * DM + lane * EPL + 4 * k); v[4 * k] = x.x; v[4 * k + 1] = x.y; v[4 * k + 2] = x.z; v[4 * k + 3] = x.w; }
    float mx = 0.f;
#pragma unroll
    for (int i = 0; i < EPL; ++i) mx = fmaxf(mx, fabsf(v[i]));
    mx = row16_max(mx);
    { float a = mx, b = mx; swap16(a, b); mx = fmaxf(mx, (threadIdx.x & 16) ? a : b); }
    mx = fmaxf(mx, partner32(mx));
    mx = fmaxf(mx, 1e-30f);
    const float inv = 6.0f / mx;
    unsigned w[U4W];
#pragma unroll
    for (int g = 0; g < U4W; ++g) {
      float a[8];
#pragma unroll
      for (int i = 0; i < 8; ++i) a[i] = v[8 * g + i] * inv;
      w[g] = pack_fp4x8(a);
    }
    if constexpr (U4W == 2) *(u32x2*)(dst + (size_t)r * DM + lane * EPL + EPL / 2) = u32x2{w[0], w[1]};
    else *(unsigned*)(dst + (size_t)r * DM + lane * EPL + EPL / 2) = w[0];
    if (lane == 0) scale[r] = mx * (1.0f / 6.0f);
  }
}
DEVFN void ph_prep(const Params& P, char* smem) {
  prep_wt(P.in[2], P.in[1], P.wt_in0, DM, EVEN_IN, smem);
  prep_wt(P.in[11], nullptr, P.wt_glu, AW, AW, smem);
  prep_wt(P.in[14], nullptr, P.wt_out0, DM, DM, smem);
  prep_wt(P.in[16], P.in[15], P.wt_q0, DM, QN, smem);
  prep_wt(P.in[22], P.in[21], P.wt_in1, DM, ODD_IN, smem);
  prep_wt(P.in[26], nullptr, P.wt_out1, DM, DM, smem);
  prep_wt(P.in[28], P.in[27], P.wt_q1, DM, QN, smem);
  const int kidx[4] = {17, 18, 29, 30};
#pragma unroll
  for (int i = 0; i < 4; ++i) cvt_bf16(P.in[kidx[i]], P.keys[i], (size_t)PH * NKEY * 128 / 4);
  prep_s5(P);
  for (int e = blockIdx.x * NT + TIDX; e < NH * 128 * 128; e += gridDim.x * NT) {
    const int t = (e >> 7) & 127, sidx = e & 127;
    P.wsb[e] = sidx <= t ? f2bf(P.in[24][e]) : (bf16_t)0;
  }
  rowstat(P.in[0], P.rinv, P.hb);
}

constexpr int GBK = 64, GLD = GBK + 8;
constexpr int GEMM_SMEM = 2 * 128 * GLD * 2;
template <class Epi>
DEVFN void gemm_tile_128(const bf16_t* __restrict__ A, int lda, const bf16_t* __restrict__ Wt, int K, int m0, int n0, char* sm, int tid, bool act, Epi& epi) {
  bf16_t* sA = (bf16_t*)sm;
  bf16_t* sB = sA + 128 * GLD;
  const int lane = tid & 63, wid = tid >> 6;
  const int wm = (wid >> 1) * 64, wn = (wid & 1) * 64;
  const int lr = tid >> 3, lc = (tid & 7) * 8;
  f32x16 acc[2][2];
#pragma unroll
  for (int i = 0; i < 2; ++i)
#pragma unroll
    for (int j = 0; j < 2; ++j)
#pragma unroll
      for (int r = 0; r < 16; ++r) acc[i][j][r] = 0.f;
  u32x4 ra[4], rb[4];
#pragma unroll
  for (int p = 0; p < 4; ++p) {
    ra[p] = *(const u32x4*)(A + (size_t)(m0 + lr + 32 * p) * lda + lc);
    rb[p] = *(const u32x4*)(Wt + (size_t)(n0 + lr + 32 * p) * K + lc);
  }
  for (int k0 = 0; k0 < K; k0 += GBK) {
    __syncthreads();
#pragma unroll
    for (int p = 0; p < 4; ++p) {
      *(u32x4*)(sA + (lr + 32 * p) * GLD + lc) = ra[p];
      *(u32x4*)(sB + (lr + 32 * p) * GLD + lc) = rb[p];
    }
    __syncthreads();
    {
      const int kn = (k0 + GBK < K) ? (k0 + GBK) : k0;
#pragma unroll
      for (int p = 0; p < 4; ++p) {
        ra[p] = *(const u32x4*)(A + (size_t)(m0 + lr + 32 * p) * lda + kn + lc);
        rb[p] = *(const u32x4*)(Wt + (size_t)(n0 + lr + 32 * p) * K + kn + lc);
      }
    }
#pragma unroll
    for (int kk = 0; kk < GBK; kk += 16) {
      bf16x8 fa[2], fb[2];
#pragma unroll
      for (int i = 0; i < 2; ++i) fa[i] = *(const bf16x8*)(sA + (wm + 32 * i + (lane & 31)) * GLD + kk + 8 * (lane >> 5));
#pragma unroll
      for (int j = 0; j < 2; ++j) fb[j] = *(const bf16x8*)(sB + (wn + 32 * j + (lane & 31)) * GLD + kk + 8 * (lane >> 5));
#pragma unroll
      for (int i = 0; i < 2; ++i)
#pragma unroll
        for (int j = 0; j < 2; ++j) acc[i][j] = mfma32(fa[i], fb[j], acc[i][j]);
    }
  }
  if (act) {
#pragma unroll
    for (int i = 0; i < 2; ++i)
#pragma unroll
      for (int j = 0; j < 2; ++j)
#pragma unroll
        for (int r = 0; r < 16; ++r) {
          int row = m0 + wm + 32 * i + (r & 3) + 8 * (r >> 2) + 4 * (lane >> 5);
          int col = n0 + wn + 32 * j + (lane & 31);
          epi(row, col, acc[i][j][r]);
        }
  }
}
struct EpiScaleBf16 {
  const float* rinv; bf16_t* out; int ldo;
  DEVFN void operator()(int row, int col, float v) { out[(size_t)row * ldo + col] = f2bf(rinv ? v * rinv[row] : v); }
};
struct EpiGlu {
  const bf16_t* ypre; const float* bias; bf16_t* out;
  DEVFN void operator()(int row, int col, float v) {
    float y = bf2f(ypre[(size_t)row * AW + col]);
    out[(size_t)row * DM + col] = f2bf(y * sigmoid_f(v + bias[col]));
  }
};
struct EpiResidual {
  const float* hin; float* hout; bf16_t* hb;
  DEVFN void operator()(int row, int col, float v) {
    size_t o = (size_t)row * DM + col;
    float h = hin[o] + v; hout[o] = h; hb[o] = f2bf(h);
  }
};
template <class Epi>
DEVFN void ph_gemm(const bf16_t* __restrict__ A, int lda, const bf16_t* __restrict__ Wt, int K, int N, Epi epi, char* smem) {
  const int sub = TIDX >> 8, stid = TIDX & 255;
  const int ntn = N / 128, ntiles = (T / 128) * ntn;
  const int stride = gridDim.x * 2;
  const int iters = (ntiles + stride - 1) / stride;
  for (int it = 0; it < iters; ++it) {
    int vb = (it * gridDim.x + blockIdx.x) * 2 + sub;
    const bool act = vb < ntiles;
    if (!act) vb = ntiles - 1;
    gemm_tile_128(A, lda, Wt, K, (vb / ntn) * 128, (vb % ntn) * 128, smem + sub * GEMM_SMEM, stid, act, epi);
  }
}


#ifndef HOST_EMU
namespace pg8 {
#define PG8_LAS __attribute__((address_space(3)))
constexpr int BM = 256, BK = 64, HALF = 128, HTB = HALF * BK * 2  , STAGE_BYTES = 8 * HTB, NXCD = 8, WGM = 8;
__host__ __device__ __forceinline__ int lds_byte(int r, int c) { const int st = (r >> 4) * 2 + (c >> 5), rr = r & 15, cc = c & 31, ob = rr * 64 + cc * 2; return st * 1024 + (ob ^ (((ob >> 9) & 1) << 5)); }
__host__ __device__ __forceinline__ void stage_rc(int b, int& R, int& C) { const int st = b / 1024, sb = b % 1024, swz = sb ^ (((sb >> 9) & 1) << 5); R = (st >> 1) * 16 + swz / 64; C = (st & 1) * 32 + (swz % 64) / 2; }
__host__ __device__ __forceinline__ int perm32(int rho) { const int n = rho >> 4, i = rho & 15; return 8 * (i >> 2) + 4 * n + (i & 3); }
struct Unit { int pm, pn; };
struct Gemm { const bf16_t* A; const bf16_t* Bt; int M, N, K; };
struct StaticOrder {
    int nM, nN, nwg, G, c;
    __host__ __device__ void init(int M, int N, int G_, int c_) { nM = M / BM; nN = N / BM; nwg = nM * nN; G = G_; c = c_; }
    __host__ __device__ bool next(int i, Unit& u) const {
        const long L = (long)i * G + c; if (L >= nwg) return false;
        int wgid = (int)L; { const int q = nwg / NXCD, r = nwg % NXCD, xcd = wgid % NXCD, off = wgid / NXCD; wgid = (xcd < r ? xcd * (q + 1) : r * (q + 1) + (xcd - r) * q) + off; }
        const int nig = WGM * nN, gid = wgid / nig, fm = gid * WGM, gsz = (nM - fm) < WGM ? (nM - fm) : WGM;
        u.pm = fm + ((wgid % nig) % gsz); u.pn = (wgid % nig) / gsz; return true;
    }
    __device__ __forceinline__ void a_ready(const Unit&) const {}
    __device__ __forceinline__ void done(const Unit&) const {}
};
__device__ __forceinline__ unsigned cvt_pk_bf16(float lo, float hi) { unsigned r; asm volatile("v_cvt_pk_bf16_f32 %0, %1, %2" : "=v"(r) : "v"(lo), "v"(hi)); return r; }
struct PEpiScaleBf16 {
    static constexpr bool PERM = true, AFTER_DRAIN = false;
    const float* rinv; bf16_t* out; int ldo;
    __device__ __forceinline__ void operator()(const f32x4 (&acc)[2][2][4][2], const Unit& u, int wr, int wc, int fr, int fq) const {
        const int row0 = u.pm * BM + wr * 64 + fr, col0 = u.pn * BM + wc * 32 + 8 * fq;
#pragma unroll
        for (int ai = 0; ai < 2; ++ai)
#pragma unroll
            for (int m = 0; m < 4; ++m) { const int row = row0 + ai * HALF + m * 16; const float sc = rinv ? rinv[row] : 1.0f; bf16_t* rowp = out + (size_t)row * ldo + col0;
#pragma unroll
                for (int bj = 0; bj < 2; ++bj) { const f32x4 v0 = acc[ai][bj][m][0] * sc, v1 = acc[ai][bj][m][1] * sc;
                    u32x4 w; w.x = cvt_pk_bf16(v0[0], v0[1]); w.y = cvt_pk_bf16(v0[2], v0[3]); w.z = cvt_pk_bf16(v1[0], v1[1]); w.w = cvt_pk_bf16(v1[2], v1[3]);
                    *(u32x4*)(rowp + bj * HALF) = w; } }
    }
};
struct PEpiGlu {
    static constexpr bool PERM = true, AFTER_DRAIN = false;
    const bf16_t* ypre; const float* bias; bf16_t* out;
    __device__ __forceinline__ void operator()(const f32x4 (&acc)[2][2][4][2], const Unit& u, int wr, int wc, int fr, int fq) const {
        const int row0 = u.pm * BM + wr * 64 + fr, col0 = u.pn * BM + wc * 32 + 8 * fq;
#pragma unroll
        for (int ai = 0; ai < 2; ++ai)
#pragma unroll
            for (int m = 0; m < 4; ++m) { const int row = row0 + ai * HALF + m * 16;
#pragma unroll
                for (int bj = 0; bj < 2; ++bj) { const int col = col0 + bj * HALF;
                    const f32x4 b0 = *(const f32x4*)(bias + col), b1 = *(const f32x4*)(bias + col + 4);
                    const u32x4 yp = *(const u32x4*)(ypre + (size_t)row * AW + col);
                    const f32x4 g0 = acc[ai][bj][m][0] + b0, g1 = acc[ai][bj][m][1] + b1;
                    u32x4 w;
                    w.x = cvt_pk_bf16(bflo(yp.x) * sigmoid_f(g0[0]), bfhi(yp.x) * sigmoid_f(g0[1])); w.y = cvt_pk_bf16(bflo(yp.y) * sigmoid_f(g0[2]), bfhi(yp.y) * sigmoid_f(g0[3]));
                    w.z = cvt_pk_bf16(bflo(yp.z) * sigmoid_f(g1[0]), bfhi(yp.z) * sigmoid_f(g1[1])); w.w = cvt_pk_bf16(bflo(yp.w) * sigmoid_f(g1[2]), bfhi(yp.w) * sigmoid_f(g1[3]));
                    *(u32x4*)(out + (size_t)row * DM + col) = w; } }
    }
};
struct PEpiResidual {
    static constexpr bool PERM = true, AFTER_DRAIN = false;
    const float* hin; float* hout; bf16_t* hb;
    __device__ __forceinline__ void operator()(const f32x4 (&acc)[2][2][4][2], const Unit& u, int wr, int wc, int fr, int fq) const {
        const int row0 = u.pm * BM + wr * 64 + fr, col0 = u.pn * BM + wc * 32 + 8 * fq;
#pragma unroll
        for (int ai = 0; ai < 2; ++ai)
#pragma unroll
            for (int m = 0; m < 4; ++m) { const int row = row0 + ai * HALF + m * 16;
#pragma unroll
                for (int bj = 0; bj < 2; ++bj) { const size_t o = (size_t)row * DM + col0 + bj * HALF;
                    const f32x4 v0 = *(const f32x4*)(hin + o) + acc[ai][bj][m][0], v1 = *(const f32x4*)(hin + o + 4) + acc[ai][bj][m][1];
                    *(f32x4*)(hout + o) = v0; *(f32x4*)(hout + o + 4) = v1;
                    u32x4 w; w.x = cvt_pk_bf16(v0[0], v0[1]); w.y = cvt_pk_bf16(v0[2], v0[3]); w.z = cvt_pk_bf16(v1[0], v1[1]); w.w = cvt_pk_bf16(v1[2], v1[3]);
                    *(u32x4*)(hb + o) = w; } }
    }
};
template <class Epi, class Sched>
__device__ __forceinline__ void gemm_phase(PG8_LAS unsigned char* lds, const Gemm g, const Sched& S, const Epi& E) {
    const int tid = opaque_tid(), wid = __builtin_amdgcn_readfirstlane(tid >> 6), lane = tid & 63, wr = wid >> 2, wc = wid & 3, fr = lane & 15, fq = lane >> 4;
    const int K = g.K, nt = K / BK;
    unsigned voffA[2], voffB[2];
#pragma unroll
    for (int i = 0; i < 2; ++i) { int R, C; stage_rc(tid * 16 + i * 8192, R, C); const int Rb = Epi::PERM ? ((R & ~31) + perm32(R & 31)) : R;
        voffA[i] = (unsigned)(R * K + C) * 2u; voffB[i] = (unsigned)(Rb * K + C) * 2u; }
    const size_t kstep = (size_t)(BK * 2);
    const size_t hstep = (size_t)HALF * K * 2;
    const size_t tstep = 2 * hstep;
    const unsigned ldsw = (unsigned)wid * 1024u;
    const int aoff = lds_byte(wr * 64 + fr, fq * 8), boff = lds_byte(wc * 32 + fr, fq * 8);
#define PG8_SA(b, h) (((b) * 2 + (h)) * HTB)
#define PG8_SB(b, h) ((4 + (b) * 2 + (h)) * HTB)
#define PG8_STAGE(bufoff, gbase, voff) do { _Pragma("unroll") for (int _i = 0; _i < 2; ++_i) \
        __builtin_amdgcn_global_load_lds((const unsigned*)((const char*)(gbase) + (voff)[_i]), (PG8_LAS unsigned*)(lds + (bufoff) + ldsw + _i * 8192), 16, 0, 0); } while (0)
#define PG8_LDA(dst, b, h) do { _Pragma("unroll") for (int m = 0; m < 4; ++m) _Pragma("unroll") for (int k = 0; k < 2; ++k) dst[m][k] = *(const PG8_LAS bf16x8*)(lds + PG8_SA(b, h) + aoff + m * 2048 + k * 1024); } while (0)
#define PG8_LDB(dst, b, h) do { _Pragma("unroll") for (int n = 0; n < 2; ++n) _Pragma("unroll") for (int k = 0; k < 2; ++k) dst[n][k] = *(const PG8_LAS bf16x8*)(lds + PG8_SB(b, h) + boff + n * 2048 + k * 1024); } while (0)
#define PG8_MMA(ai, bj, At, Bt) do { __builtin_amdgcn_s_setprio(1); _Pragma("unroll") for (int m = 0; m < 4; ++m) _Pragma("unroll") for (int n = 0; n < 2; ++n) _Pragma("unroll") for (int k = 0; k < 2; ++k) \
        acc[ai][bj][m][n] = __builtin_amdgcn_mfma_f32_16x16x32_bf16(Bt[n][k], At[m][k], acc[ai][bj][m][n], 0, 0, 0); __builtin_amdgcn_s_setprio(0); } while (0)
#define PG8_WAIT_V(n) asm volatile("s_waitcnt vmcnt(" #n ")" ::: "memory")
#define PG8_WAIT_L(n) asm volatile("s_waitcnt lgkmcnt(" #n ")" ::: "memory")
#define PG8_BAR __builtin_amdgcn_s_barrier()
#define PG8_SCHED __builtin_amdgcn_sched_barrier(0)
    Unit cur, nxt; int ui = 0;
    if (!S.next(0, cur)) return;
    f32x4 acc[2][2][4][2];
#pragma unroll
    for (int a = 0; a < 2; ++a)
#pragma unroll
        for (int b = 0; b < 2; ++b)
#pragma unroll
            for (int m = 0; m < 4; ++m)
#pragma unroll
                for (int n = 0; n < 2; ++n) acc[a][b][m][n] = (f32x4){0.f, 0.f, 0.f, 0.f};
    bf16x8 At[4][2], B0[2][2], B1[2][2];
    const char* cA = (const char*)g.A + (size_t)cur.pm * tstep; const char* cB = (const char*)g.Bt + (size_t)cur.pn * tstep;
    S.a_ready(cur);
    PG8_STAGE(PG8_SB(0, 0), cB, voffB); PG8_STAGE(PG8_SA(0, 0), cA, voffA); PG8_STAGE(PG8_SB(0, 1), cB + hstep, voffB); PG8_STAGE(PG8_SA(0, 1), cA + hstep, voffA);
    if (wr == 1) PG8_BAR;
    PG8_WAIT_V(4); PG8_BAR;
    PG8_STAGE(PG8_SB(1, 0), cB + kstep, voffB); PG8_STAGE(PG8_SA(1, 0), cA + kstep, voffA); PG8_STAGE(PG8_SB(1, 1), cB + hstep + kstep, voffB);
    PG8_WAIT_V(6); PG8_BAR;
    for (;;) {
        const bool has_next = S.next(ui + 1, nxt);
        const char* nA = has_next ? (const char*)g.A + (size_t)nxt.pm * tstep : cA; const char* nB = has_next ? (const char*)g.Bt + (size_t)nxt.pn * tstep : cB;
        for (int t = 0; t < nt; t += 2) {
            const bool last = (t == nt - 2);
            const char* a1 = cA + (size_t)(t + 1) * kstep;
            const char* a2 = last ? nA : cA + (size_t)(t + 2) * kstep; const char* b2 = last ? nB : cB + (size_t)(t + 2) * kstep;
            const char* a3 = a2 + kstep; const char* b3 = b2 + kstep;
            if (last && has_next) S.a_ready(nxt);
            PG8_LDB(B0, 0, 0); PG8_SCHED; PG8_LDA(At, 0, 0); PG8_STAGE(PG8_SA(1, 1), a1 + hstep, voffA);
            PG8_WAIT_L(8); PG8_BAR; PG8_WAIT_L(0); PG8_MMA(0, 0, At, B0); PG8_BAR; PG8_SCHED;
            PG8_LDB(B1, 0, 1); PG8_STAGE(PG8_SB(0, 0), b2, voffB);
            PG8_BAR; PG8_WAIT_L(0); PG8_MMA(0, 1, At, B1); PG8_BAR;
            PG8_LDA(At, 0, 1); PG8_STAGE(PG8_SA(0, 0), a2, voffA);
            PG8_BAR; PG8_WAIT_L(0); PG8_MMA(1, 0, At, B0); PG8_BAR; PG8_SCHED;
            PG8_STAGE(PG8_SB(0, 1), b2 + hstep, voffB);
            PG8_WAIT_V(6); PG8_BAR; PG8_MMA(1, 1, At, B1); PG8_BAR;
            PG8_LDB(B0, 1, 0); PG8_SCHED; PG8_LDA(At, 1, 0); PG8_STAGE(PG8_SA(0, 1), a2 + hstep, voffA);
            PG8_WAIT_L(8); PG8_BAR; PG8_WAIT_L(0); PG8_MMA(0, 0, At, B0); PG8_BAR; PG8_SCHED;
            PG8_LDB(B1, 1, 1); PG8_STAGE(PG8_SB(1, 0), b3, voffB);
            PG8_BAR; PG8_WAIT_L(0); PG8_MMA(0, 1, At, B1); PG8_BAR;
            PG8_LDA(At, 1, 1); PG8_STAGE(PG8_SA(1, 0), a3, voffA);
            PG8_BAR; PG8_WAIT_L(0); PG8_MMA(1, 0, At, B0); PG8_BAR; PG8_SCHED;
            PG8_STAGE(PG8_SB(1, 1), b3 + hstep, voffB);
            PG8_WAIT_V(6); PG8_BAR; PG8_MMA(1, 1, At, B1); PG8_BAR;
        }
        if constexpr (!Epi::AFTER_DRAIN) { E(acc, cur, wr, wc, fr, fq); S.done(cur); }
        if (!has_next) break;
#pragma unroll
        for (int a = 0; a < 2; ++a)
#pragma unroll
            for (int b = 0; b < 2; ++b)
#pragma unroll
                for (int m = 0; m < 4; ++m)
#pragma unroll
                    for (int n = 0; n < 2; ++n) acc[a][b][m][n] = (f32x4){0.f, 0.f, 0.f, 0.f};
        cur = nxt; cA = nA; cB = nB; ++ui;
    }
    PG8_WAIT_V(0);
    if (wr == 0) PG8_BAR;
    PG8_BAR;
    if constexpr (Epi::AFTER_DRAIN) { E.fused(acc, cur, wr, wc, fr, fq, lds, wid, lane); S.done(cur); }
#undef PG8_SA
#undef PG8_SB
#undef PG8_STAGE
#undef PG8_LDA
#undef PG8_LDB
#undef PG8_MMA
#undef PG8_WAIT_V
#undef PG8_WAIT_L
#undef PG8_BAR
#undef PG8_SCHED
}

}
template <class PEpi>
DEVFN void ph_gemm8(const bf16_t* A, const bf16_t* Wt, int K, int N, const PEpi& E, char* smem) {
  pg8::StaticOrder S; S.init(T, N, (int)gridDim.x, (int)blockIdx.x);
  pg8::gemm_phase<PEpi, pg8::StaticOrder>((PG8_LAS unsigned char*)smem, pg8::Gemm{A, Wt, T, N, K}, S, E);
}
#define GEMM_SCALE(A, Wt, K, N, rinvp, outp) ph_gemm8(A, Wt, K, N, pg8::PEpiScaleBf16{rinvp, outp, N}, smem)
#define GEMM_GLU(A, Wt, K, N, yprep, biasp, outp) ph_gemm8(A, Wt, K, N, pg8::PEpiGlu{yprep, biasp, outp}, smem)
#define GEMM_RES(A, Wt, K, N, hinp, houtp, hbp) ph_gemm8(A, Wt, K, N, pg8::PEpiResidual{hinp, houtp, hbp}, smem)
#else
#define GEMM_SCALE(A, Wt, K, N, rinvp, outp) ph_gemm(A, K, Wt, K, N, EpiScaleBf16{rinvp, outp, N}, smem)
#define GEMM_GLU(A, Wt, K, N, yprep, biasp, outp) ph_gemm(A, K, Wt, K, N, EpiGlu{yprep, biasp, outp}, smem)
#define GEMM_RES(A, Wt, K, N, hinp, houtp, hbp) ph_gemm(A, K, Wt, K, N, EpiResidual{hinp, houtp, hbp}, smem)
#endif

DEVFN void s5_bu(const bf16_t* __restrict__ pb, const S5Tab& tb, int tok0, int g, int lane, int pp, f32x16 (&acc)[2][2]) {
  const int half = lane >> 5, i = lane & 31;
  const int tau = 16 * ((i >> 2) & 1) + 4 * (i >> 3) + (i & 3);
  bf16x8 au[2], bb[2];
#pragma unroll
  for (int mt = 0; mt < 2; ++mt) au[mt] = *(const bf16x8*)(pb + (size_t)(tok0 + mt * 32 + tau) * EVEN_IN + g * 16 + 8 * half);
#pragma unroll
  for (int part = 0; part < 2; ++part) bb[part] = *(const bf16x8*)(tb.bbT + ((size_t)g * 128 + (2 * part + pp) * 32 + i) * 16 + 8 * half);
#pragma unroll
  for (int mt = 0; mt < 2; ++mt)
#pragma unroll
    for (int part = 0; part < 2; ++part) {
#pragma unroll
      for (int r = 0; r < 16; ++r) acc[mt][part][r] = 0.f;
      acc[mt][part] = mfma32(au[mt], bb[part], acc[mt][part]);
    }
}
DEVFN void s5_local_scan(f32x16 (&acc)[2][2], float ar, float ai) {
#pragma unroll
  for (int mt = 0; mt < 2; ++mt)
#pragma unroll
    for (int k = 1; k < 16; ++k) {
      const float pr = acc[mt][0][k - 1], pi = acc[mt][1][k - 1];
      acc[mt][0][k] += ar * pr - ai * pi;
      acc[mt][1][k] += ar * pi + ai * pr;
    }
}
DEVFN void s5_carries(const f32x16 (&acc)[2][2], int half, float a16r, float a16i, float c0r, float c0i, float (&csr)[5], float (&csi)[5]) {
  float er[4], ei[4];
#pragma unroll
  for (int mt = 0; mt < 2; ++mt) {
    const float ownr = acc[mt][0][15], owni = acc[mt][1][15];
    const float parr = partner32(ownr), pari = partner32(owni);
    er[2 * mt] = half ? parr : ownr; ei[2 * mt] = half ? pari : owni;
    er[2 * mt + 1] = half ? ownr : parr; ei[2 * mt + 1] = half ? owni : pari;
  }
  csr[0] = c0r; csi[0] = c0i;
#pragma unroll
  for (int j = 0; j < 4; ++j) { csr[j + 1] = a16r * csr[j] - a16i * csi[j] + er[j]; csi[j + 1] = a16r * csi[j] + a16i * csr[j] + ei[j]; }
}
DEVFN void ph_s5_pass1(const Params& P) {
  const int tid = TIDX, lane = tid & 63, wv = tid >> 6, half = lane >> 5;
  const S5Tab& tb = P.tb;
  for (int item = blockIdx.x * NWV + wv; item < NB * NCH * NG; item += gridDim.x * NWV) {
    const int g = item % NG, ch = (item / NG) % NCH, b = item / (NG * NCH);
    float* dst = P.S + ((size_t)(b * NCH + ch) * NG + g) * 128;
#pragma unroll
    for (int pp = 0; pp < 2; ++pp) {
      const int p = pp * 32 + (lane & 31);
      f32x16 acc[2][2];
      s5_bu(P.pb, tb, b * SEQ + ch * SQ, g, lane, pp, acc);
      s5_local_scan(acc, tb.ar[g * NST + p], tb.ai[g * NST + p]);
      float csr[5], csi[5];
      s5_carries(acc, half, tb.a16r[g * NST + p], tb.a16i[g * NST + p], 0.f, 0.f, csr, csi);
      if (half == 0) { dst[p] = csr[4]; dst[64 + p] = csi[4]; }
    }
  }
}
DEVFN void ph_s5_pass2(const Params& P) {
  for (int gid = blockIdx.x * NT + TIDX; gid < NB * NG * NST; gid += gridDim.x * NT) {
  const int p = gid % NST, g = (gid / NST) % NG, b = gid / (NST * NG), gp = g * NST + p;
  const float qr = P.tb.aqr[gp], qi = P.tb.aqi[gp];
  const float* __restrict__ S = P.S; float* __restrict__ S2 = P.S2;
  float hr = 0.f, hi = 0.f;
  for (int c0 = 0; c0 < NCH; c0 += 8) {
    float sr[8], si[8];
#pragma unroll
    for (int j = 0; j < 8; ++j) { const float* d = S + ((size_t)(b * NCH + c0 + j) * NG + g) * 128; sr[j] = d[p]; si[j] = d[64 + p]; }
#pragma unroll
    for (int j = 0; j < 8; ++j) {
      float* d = S2 + ((size_t)(b * NCH + c0 + j) * NG + g) * 128;
      d[p] = hr; d[64 + p] = hi;
      float nr = qr * hr - qi * hi + sr[j], ni = qr * hi + qi * hr + si[j];
      hr = nr; hi = ni;
    }
  }
  }
}
constexpr int HLD = 128 + 8;
DEVFN void ph_s5_pass3(const Params& P, char* smem) {
  const int tid = TIDX, lane = tid & 63, wv = tid >> 6, half = lane >> 5, l31 = lane & 31;
  bf16_t* Hl = (bf16_t*)(smem + wv * (64 * HLD * 2));
  const S5Tab& tb = P.tb;
  for (int item = blockIdx.x * NWV + wv; item < NB * NCH * NG; item += gridDim.x * NWV) {
    const int g = item % NG, ch = (item / NG) % NCH, b = item / (NG * NCH);
    const int tok0 = b * SEQ + ch * SQ;
    const float* src = P.S2 + ((size_t)(b * NCH + ch) * NG + g) * 128;
    WAVE_SYNC();
#pragma unroll
    for (int pp = 0; pp < 2; ++pp) {
      const int p = pp * 32 + l31;
      const float ar = tb.ar[g * NST + p], ai = tb.ai[g * NST + p];
      f32x16 acc[2][2];
      s5_bu(P.pb, tb, tok0, g, lane, pp, acc);
      s5_local_scan(acc, ar, ai);
      float csr[5], csi[5];
      s5_carries(acc, half, tb.a16r[g * NST + p], tb.a16i[g * NST + p], src[p], src[64 + p], csr, csi);
#pragma unroll
      for (int mt = 0; mt < 2; ++mt) {
        const float cr = half ? csr[2 * mt + 1] : csr[2 * mt], ci = half ? csi[2 * mt + 1] : csi[2 * mt];
        float pr = ar, pi = ai;
#pragma unroll
        for (int k = 0; k < 16; ++k) {
          const float hr = acc[mt][0][k] + pr * cr - pi * ci, hi = acc[mt][1][k] + pr * ci + pi * cr;
          const float nr = pr * ar - pi * ai, ni = pr * ai + pi * ar;
          pr = nr; pi = ni;
          *(unsigned*)(Hl + (mt * 32 + 16 * half + k) * HLD + 4 * l31 + 2 * pp) = pack2(hr, hi);
        }
      }
    }
    WAVE_SYNC();
    f32x16 y[2];
#pragma unroll
    for (int mt = 0; mt < 2; ++mt)
#pragma unroll
      for (int r = 0; r < 16; ++r) y[mt][r] = 0.f;
    const bf16x8 zero8 = {0, 0, 0, 0, 0, 0, 0, 0};
#pragma unroll
    for (int ks = 0; ks < 9; ++ks) {
      const bf16x8 fb = l31 < 16 ? *(const bf16x8*)(tb.cmP + ((size_t)g * 16 + l31) * CMK + ks * 16 + 8 * half) : zero8;
#pragma unroll
      for (int mt = 0; mt < 2; ++mt) {
        const bf16x8 fa = ks < 8 ? *(const bf16x8*)(Hl + (mt * 32 + l31) * HLD + ks * 16 + 8 * half)
                                 : *(const bf16x8*)(P.pb + (size_t)(tok0 + mt * 32 + l31) * EVEN_IN + g * 16 + 8 * half);
        y[mt] = mfma32(fa, fb, y[mt]);
      }
    }
    if (l31 < 16) {
#pragma unroll
      for (int mt = 0; mt < 2; ++mt)
#pragma unroll
        for (int r = 0; r < 16; ++r) {
          const int t = mt * 32 + (r & 3) + 8 * (r >> 2) + 4 * half;
          P.ya[(size_t)(tok0 + t) * AW + g * 16 + l31] = f2bf(gelu_f(y[mt][r]));
        }
    }
  }
}

DEVFN void ph_conv(const Params& P) {
  const bf16_t* __restrict__ pb = P.pb; const float* __restrict__ cw = P.in[13]; bf16_t* __restrict__ cb = P.cb;
  const int per_row = AW / 8;
  for (int e = blockIdx.x * NT + TIDX; e < T * per_row; e += gridDim.x * NT) {
    const int t = e / per_row, c0 = (e % per_row) * 8;
    const int l = t % SEQ;
    const bf16_t* row = pb + (size_t)t * EVEN_IN;
    float acc[8];
#pragma unroll
    for (int j = 0; j < 8; ++j) acc[j] = 0.f;
#pragma unroll
    for (int d = 0; d < 3; ++d) {
      if (l - 2 + d < 0) continue;
      const bf16_t* r2 = row - (size_t)(2 - d) * EVEN_IN;
      u32x4 cg = *(const u32x4*)(r2 + 2 * AW + c0), xi = *(const u32x4*)(r2 + 3 * AW + c0);
      const unsigned cgs[4] = {cg.x, cg.y, cg.z, cg.w}, xis[4] = {xi.x, xi.y, xi.z, xi.w};
#pragma unroll
      for (int j = 0; j < 4; ++j) {
        acc[2 * j] += cw[d * AW + c0 + 2 * j] * bflo(cgs[j]) * bflo(xis[j]);
        acc[2 * j + 1] += cw[d * AW + c0 + 2 * j + 1] * bfhi(cgs[j]) * bfhi(xis[j]);
      }
    }
    u32x4 bg = *(const u32x4*)(row + AW + c0);
    const unsigned bgs[4] = {bg.x, bg.y, bg.z, bg.w};
    unsigned w[4];
#pragma unroll
    for (int j = 0; j < 4; ++j) w[j] = pack2(bflo(bgs[j]) * acc[2 * j], bfhi(bgs[j]) * acc[2 * j + 1]);
    *(u32x4*)(cb + (size_t)t * DM + AW + c0) = u32x4{w[0], w[1], w[2], w[3]};
  }
}

DEVFN int f2key(float f) { const int b = __builtin_bit_cast(int, f); return b ^ ((b >> 31) & 0x7fffffff); }
DEVFN float key2f(int k) { return __builtin_bit_cast(float, k ^ ((k >> 31) & 0x7fffffff)); }
DEVFN int imax(int a, int b) { return a > b ? a : b; }
DEVFN int imin(int a, int b) { return a < b ? a : b; }
DEVFN void cmpx(int& a, int& b) { const int hi = imax(a, b), lo = imin(a, b); a = hi; b = lo; }
DEVFN void merge_partner(int (&v)[16]) {
  int pv[16];
#pragma unroll
  for (int k = 0; k < 16; ++k) pv[k] = __shfl_xor(v[k], 32);
#pragma unroll
  for (int k = 0; k < 16; ++k) v[k] = imax(v[k], pv[15 - k]);
#pragma unroll
  for (int st = 8; st >= 1; st >>= 1)
#pragma unroll
    for (int k = 0; k < 16; ++k)
      if ((k & st) == 0) cmpx(v[k], v[k + st]);
}
DEVFN void sort16_desc(int (&v)[16]) {
#pragma unroll
  for (int k = 2; k <= 16; k <<= 1)
#pragma unroll
    for (int j = k >> 1; j >= 1; j >>= 1)
#pragma unroll
      for (int i = 0; i < 16; ++i) {
        const int l = i ^ j;
        if (l > i) { if ((i & k) == 0) cmpx(v[i], v[l]); else cmpx(v[l], v[i]); }
      }
}
DEVFN void merge16_desc(int (&a)[16], const int (&b)[16]) {
#pragma unroll
  for (int k = 0; k < 16; ++k) a[k] = imax(a[k], b[15 - k]);
#pragma unroll
  for (int st = 8; st >= 1; st >>= 1)
#pragma unroll
    for (int k = 0; k < 16; ++k)
      if ((k & st) == 0) cmpx(a[k], a[k + st]);
}
constexpr int KLD = 128 + 8;
DEVFN void topk_part(const bf16_t* __restrict__ qp, const bf16_t* sk, int lane, int half, int (&kv)[16]) {
  f32x16 acc[4];
#pragma unroll
  for (int mi = 0; mi < 4; ++mi)
#pragma unroll
    for (int r = 0; r < 16; ++r) acc[mi][r] = 0.f;
#pragma unroll
  for (int s = 0; s < 8; ++s) {
    const bf16x8 fb = *(const bf16x8*)(qp + s * 16);
#pragma unroll
    for (int mi = 0; mi < 4; ++mi) {
      const bf16x8 fa = *(const bf16x8*)(sk + (mi * 32 + (lane & 31)) * KLD + s * 16 + 8 * half);
      acc[mi] = mfma32(fa, fb, acc[mi]);
    }
  }
  const int hb = 4 * half;
  int g[4][16];
#pragma unroll
  for (int mi = 0; mi < 4; ++mi) {
#pragma unroll
    for (int r = 0; r < 16; ++r) g[mi][r] = (f2key(acc[mi][r]) & ~127) | (127 - (mi * 32 + (r & 3) + 8 * (r >> 2)) - hb);
    sort16_desc(g[mi]);
  }
  merge16_desc(g[0], g[1]); merge16_desc(g[2], g[3]); merge16_desc(g[0], g[2]);
#pragma unroll
  for (int k = 0; k < 16; ++k) kv[k] = g[0][k];
  merge_partner(kv);
}
constexpr int pair_ab(int idx) { int n = 0; for (int a = 0; a < 16; ++a) for (int b = 0; b < 16; ++b) if ((a + 1) * (b + 1) <= 16) { if (n == idx) return a * 16 + b; ++n; } return 0; }
template <int I> DEVFN void cand_step(const float (&v1f)[16], const float (&v2f)[16], int half, int (&ck)[16]) {
  constexpr int p0 = pair_ab(2 * I), p1 = pair_ab(2 * I + 1);
  const float s0 = v1f[p0 >> 4] + v2f[p0 & 15], s1 = v1f[p1 >> 4] + v2f[p1 & 15];
  int x = (f2key(half ? s1 : s0) & ~255) | (half ? (255 - p1) : (255 - p0));
#pragma unroll
  for (int k = 0; k < 16; ++k) if (k < I) cmpx(ck[k], x);
  if (I < 16) ck[I < 16 ? I : 0] = x;
}
template <int... I> DEVFN void cand_all(const float (&v1f)[16], const float (&v2f)[16], int half, int (&ck)[16], std::integer_sequence<int, I...>) { (cand_step<I>(v1f, v2f, half, ck), ...); }
DEVFN void ph_topk(const bf16_t* __restrict__ q, const bf16_t* __restrict__ k1, const bf16_t* __restrict__ k2,
                   int* __restrict__ idx_out, float* __restrict__ gate_out, char* smem) {
  bf16_t* sk = (bf16_t*)smem;
  const int tid = TIDX, lane = tid & 63, wv = tid >> 6, half = lane >> 5;
  unsigned char* lut = (unsigned char*)(smem + 2 * 128 * KLD * 2) + (wv * 64 + lane) * 32;
  constexpr int NITEM = (T / 256) * PH;
  const int iters = (NITEM + gridDim.x - 1) / gridDim.x;
  int h_lds = -1;
  for (int it = 0; it < iters; ++it) {
    const int item = it * gridDim.x + blockIdx.x;
    const bool act = item < NITEM;
    const int h = item % PH, tile = item / PH;
    if (h != h_lds) {
      __syncthreads();
      if (act)
        for (int e = tid; e < 2 * 128 * 16; e += NT) {
          const int part = e >> 11, row = (e >> 4) & 127, c8 = (e & 15) * 8;
          *(u32x4*)(sk + (part * 128 + row) * KLD + c8) = *(const u32x4*)((part ? k2 : k1) + ((size_t)h * NKEY + row) * 128 + c8);
        }
      __syncthreads();
      h_lds = act ? h : -1;
    }
    if (!act) continue;
    const int tok = tile * 256 + wv * 32 + (lane & 31);
    int kv1[16], kv2[16];
    topk_part(q + (size_t)tok * QN + h * 256 + 8 * half, sk, lane, half, kv1);
    topk_part(q + (size_t)tok * QN + h * 256 + 128 + 8 * half, sk + 128 * KLD, lane, half, kv2);
    float v1f[16], v2f[16];
#pragma unroll
    for (int k = 0; k < 16; ++k) {
      v1f[k] = key2f(kv1[k] & ~127); v2f[k] = key2f(kv2[k] & ~127);
      lut[k] = (unsigned char)(127 - (kv1[k] & 127)); lut[16 + k] = (unsigned char)(127 - (kv2[k] & 127));
    }
    int ck[16];
    cand_all(v1f, v2f, half, ck, std::make_integer_sequence<int, 25>{});
    merge_partner(ck);
    unsigned oi[8]; float og[8];
#pragma unroll
    for (int j = 0; j < 8; ++j) {
      int k0 = ck[j], k1 = ck[8 + j];
      OPAQUE(k0); OPAQUE(k1);
      const int kk = half ? k1 : k0;
      const int pos = 255 - (kk & 255);
      oi[j] = (unsigned)lut[pos >> 4] * NKEY + (unsigned)lut[16 + (pos & 15)];
      og[j] = key2f(kk & ~255);
    }
    const size_t o = (size_t)tok * NSEL + h * TOPK + 8 * half;
    *(u32x4*)(idx_out + o) = u32x4{oi[0], oi[1], oi[2], oi[3]}; *(u32x4*)(idx_out + o + 4) = u32x4{oi[4], oi[5], oi[6], oi[7]};
    *(f32x4*)(gate_out + o) = f32x4{og[0], og[1], og[2], og[3]}; *(f32x4*)(gate_out + o + 4) = f32x4{og[4], og[5], og[6], og[7]};
  }
}

#ifdef HOST_EMU
struct XcdBarrier { int dummy; };
#endif
#ifndef HOST_EMU
#define XB_TMO      128
#define XB_XCNT(j)  (256  + 64 * (j))
#define XB_XSUB(j)  (1280 + 64 * (j))
#define XB_XGEN(j)  (2304 + 64 * (j))
#define XB_TOP      3328
#define XB_TOPGEN   3392
#define XB_PACE(j)  (3456 + 64 * (j))
#define XCD_BAR_WORDS 4480
#define XB_SPIN_CAP (1u << 20)
#define LAS __attribute__((address_space(3)))
DEVFN unsigned xb_ld(unsigned* p)              { return __hip_atomic_load(p, __ATOMIC_RELAXED, __HIP_MEMORY_SCOPE_AGENT); }
DEVFN unsigned xb_add(unsigned* p, unsigned v) { return __hip_atomic_fetch_add(p, v, __ATOMIC_RELAXED, __HIP_MEMORY_SCOPE_AGENT); }
DEVFN unsigned xb_xcc_id() { return (unsigned)__builtin_amdgcn_s_getreg((3 << 11) | 20) & 0xFu; }
#define XB_SPIN(cond, bar) do { unsigned _sp = 0; while (cond) { __builtin_amdgcn_s_sleep(1); \
    if ((++_sp & 255u) == 0u) { if (xb_ld(&(bar)[XB_TMO])) break; if (_sp > XB_SPIN_CAP) { atomicAdd(&(bar)[XB_TMO], 1u); break; } } } } while (0)
struct XcdBarrier { unsigned* bar; unsigned x; volatile LAS unsigned* st; };
DEVFN XcdBarrier xcd_barrier_post(unsigned* bar, volatile LAS unsigned* st) {
  XcdBarrier b; b.bar = bar; b.x = xb_xcc_id(); b.st = st;
  if (threadIdx.x == 0) (void)xb_add(&bar[XB_XCNT(b.x)], 1u);
  return b;
}
DEVFN void xcd_barrier_complete(unsigned* bar, unsigned x, unsigned& nloc, unsigned& nx) {
  const unsigned G = gridDim.x * gridDim.y * gridDim.z;
  unsigned sum, cnt, mine, sp = 0u;
  for (;;) {
    sum = 0u; cnt = 0u; mine = 0u;
#pragma unroll
    for (unsigned j = 0; j < 16; ++j) { const unsigned c = xb_ld(&bar[XB_XCNT(j)]); sum += c; cnt += (c > 0u) ? 1u : 0u; mine = (j == x) ? c : mine; }
    if (sum == G) break;
    __builtin_amdgcn_s_sleep(1);
    if ((++sp & 255u) == 0u) { if (xb_ld(&bar[XB_TMO])) break; if (sp > XB_SPIN_CAP) { atomicAdd(&bar[XB_TMO], 1u); break; } }
  }
  nloc = mine > 0u ? mine : 1u; nx = cnt > 0u ? cnt : 1u;
}
DEVFN void xcd_barrier(const XcdBarrier& b) {
  asm volatile("s_waitcnt vmcnt(0)" ::: "memory");
  __syncthreads();
  if (threadIdx.x == 0) {
    unsigned* bar = b.bar;
    __builtin_amdgcn_s_waitcnt(0);
    unsigned nloc = b.st[0], nx = b.st[1];
    if (nloc == 0u) { xcd_barrier_complete(bar, b.x, nloc, nx); b.st[0] = nloc; b.st[1] = nx; }
    const unsigned old = xb_add(&bar[XB_XSUB(b.x)], 1u);
    const unsigned gen = old / nloc;
    if (old + 1u == (gen + 1u) * nloc) {
      __builtin_amdgcn_fence(__ATOMIC_RELEASE, "agent");
      asm volatile("s_waitcnt vmcnt(0)" ::: "memory");
      const unsigned og = xb_add(&bar[XB_TOP], 1u);
      const unsigned tg = og / nx;
      if (og + 1u == (tg + 1u) * nx) xb_add(&bar[XB_TOPGEN], 1u);
      else XB_SPIN(xb_ld(&bar[XB_TOPGEN]) == tg, bar);
      __builtin_amdgcn_fence(__ATOMIC_ACQUIRE, "agent");
      xb_add(&bar[XB_XGEN(b.x)], 1u);
      asm volatile("s_waitcnt vmcnt(0)" ::: "memory");
    } else {
      XB_SPIN(xb_ld(&bar[XB_XGEN(b.x)]) == gen, bar);
      __builtin_amdgcn_fence(__ATOMIC_ACQUIRE, "agent");
      asm volatile("s_waitcnt vmcnt(0)" ::: "memory");
    }
  }
  __syncthreads();
}
#define XSYNC() xcd_barrier(xb)
constexpr unsigned PACE_LAG = 1;
struct XcdPace { unsigned* ctr; unsigned nloc; unsigned step; };
DEVFN unsigned sload_glc(const unsigned* p) {
  unsigned v;
  const unsigned long long a = (unsigned long long)p;
  p = (const unsigned*)(((unsigned long long)(unsigned)__builtin_amdgcn_readfirstlane((int)(a >> 32)) << 32) | (unsigned)__builtin_amdgcn_readfirstlane((int)a));
  asm volatile("s_load_dword %0, %1, 0x0 glc\n\ts_waitcnt lgkmcnt(0)" : "=s"(v) : "s"(p) : "memory");
  return v;
}
DEVFN XcdPace xcd_pace_init(const XcdBarrier& b, int which) {
  XcdPace pc; pc.ctr = b.bar + XB_PACE(b.x) + 32 * which; pc.nloc = (unsigned)__builtin_amdgcn_readfirstlane((int)b.st[0]); pc.step = 0u;
  return pc;
}
#ifndef CFG_XPACE
#define CFG_XPACE 0
#endif
DEVFN void xcd_pace(XcdPace& pc) {
  ++pc.step;
  if (CFG_XPACE && __builtin_amdgcn_readfirstlane((int)(threadIdx.x >> 6)) == 0) {
    if (threadIdx.x == 0) (void)xb_add(pc.ctr, 1u);
    if (pc.step > PACE_LAG) {
      const unsigned need = pc.nloc * (pc.step - PACE_LAG);
      if ((int)(sload_glc(pc.ctr) - need) < 0) {
        unsigned sp = 0u;
        while ((int)(xb_ld(pc.ctr) - need) < 0) { __builtin_amdgcn_s_sleep(1); if (++sp > (1u << 16)) break; }
      }
    }
  }
  __syncthreads();
}
#else
#define XCD_BAR_WORDS 3456
#define XSYNC() emu_grid_sync()
struct XcdPace { int step; };
DEVFN XcdPace xcd_pace_init(const XcdBarrier&, int) { return XcdPace{0}; }
DEVFN void xcd_pace(XcdPace& pc) { ++pc.step; __syncthreads(); }
#endif


static_assert(EW == 4 || EW == 2, "row vector width");
constexpr int IDXR = (NSEL + 63) / 64;
#ifndef CFG_GSH
#define CFG_GSH 11
#endif
#ifndef CFG_UPM
#define CFG_UPM 12
#endif
#ifndef CFG_VPM
#define CFG_VPM 4
#endif
constexpr int GSH = CFG_GSH;
constexpr int UPM = CFG_UPM;
constexpr int VPM = CFG_VPM;
constexpr int RB = 8;
struct RowBatch { unsigned w[RB][EW]; };
DEVFN void load_row(const unsigned char* __restrict__ p, int lane, unsigned (&w)[EW]) {
  if constexpr (EW == 4) { u32x4 x = *(const u32x4*)(p + lane * EPL); w[0] = x.x; w[1] = x.y; w[2] = x.z; w[3] = x.w; }
  else { u32x2 x = *(const u32x2*)(p + lane * EPL); w[0] = x.x; w[1] = x.y; }
}
constexpr int NTW = 4;
constexpr int NENT = NTW * NSEL;
constexpr int ENTR = NENT / 64;
static_assert(RB == 2 * NTW && NENT % 64 == 0 && NSEL % 16 == 0 && NSEL % 4 == 0 && (T % NTW) == 0, "gather group shape");
DEVFN int bucket_of(int e) {
  constexpr int NB = NEXP >> GSH;
  const int i = e / NKEY, j = e % NKEY;
  return ((i * NB) / NKEY + (j * NB) / NKEY) % NB;
}
DEVFN int uni_i(int v) {
#ifndef HOST_EMU
  return __builtin_amdgcn_readfirstlane(v);
#else
  return v;
#endif
}
DEVFN float uni_f(float v) { return __builtin_bit_cast(float, uni_i(__builtin_bit_cast(int, v))); }
DEVFN float dot_row(const unsigned (&w)[EW], const f32x2 (&hx)[2 * EW]) {
  f32x2 a = {0.f, 0.f};
#pragma unroll
  for (int k = 0; k < EW; ++k) { a += unpack_fp8_lo(w[k]) * hx[2 * k]; a += unpack_fp8_hi(w[k]) * hx[2 * k + 1]; }
  return a.x + a.y;
}
DEVFN void pk_fma_acc(f32x2& acc, f32x2 val, float c) {
#ifndef HOST_EMU
  const unsigned long long cs = (unsigned long long)__builtin_bit_cast(unsigned, c);
  asm("v_pk_fma_f32 %0, %1, %2, %0 op_sel_hi:[1,0,1]" : "+v"(acc) : "v"(val), "s"(cs));
#else
  acc += val * c;
#endif
}
DEVFN void axpy_row(const unsigned (&w)[EW], float c, f32x2 (&acc)[2 * EW]) {
#pragma unroll
  for (int g = 0; g < U4W; ++g) {
    pk_fma_acc(acc[4 * g], unpack_fp4<0>(w[U4W + g]), c); pk_fma_acc(acc[4 * g + 1], unpack_fp4<1>(w[U4W + g]), c);
    pk_fma_acc(acc[4 * g + 2], unpack_fp4<2>(w[U4W + g]), c); pk_fma_acc(acc[4 * g + 3], unpack_fp4<3>(w[U4W + g]), c);
  }
}
template <bool ISU>
DEVFN void gather4_load(RowBatch& B, int s0, const int* srt, int lane, int jr, const unsigned char* __restrict__ tab, const float* __restrict__ su, const float* __restrict__ sv) {
#pragma unroll
  for (int j = 0; j < RB; ++j) {
    const int e = uni_i(srt[(j % NTW) * NSEL + s0 + j / NTW]);
    load_row(tab + (size_t)e * DM, lane, B.w[j]);
  }
}
DEVFN float gather4_u(const RowBatch& B, int s0, const int (&hq)[NTW][EW], float shl, const float* sgt, const float* sut, int lane, int jr) {
  float d[RB];
#pragma unroll
  for (int j = 0; j < RB; ++j) {
    int ah = 0, al = 0;
#pragma unroll
    for (int g = 0; g < U4W; ++g) { ah = sdot8((int)B.w[j][g], hq[j % NTW][g], ah); al = sdot8((int)B.w[j][g], hq[j % NTW][U4W + g], al); }
    d[j] = (float)(16 * ah + al);
  }
  float r4[4], r2[2];
#pragma unroll
  for (int i = 0; i < 4; ++i) { swap32(d[i], d[i + 4]); r4[i] = d[i] + d[i + 4]; }
#pragma unroll
  for (int i = 0; i < 2; ++i) { swap16(r4[i], r4[i + 2]); r2[i] = r4[i] + r4[i + 2]; }
  const float t0 = r2[0] + dpp_f<0x128>(r2[0]), t1 = r2[1] + dpp_f<0x128>(r2[1]);
  float r = (lane & 8) ? t1 : t0;
  r += dpp_f<0x141>(r); r += dpp_f<0xB1>(r); r += dpp_f<0x4E>(r);
  const int li = (jr % NTW) * NSEL + s0 + jr / NTW;
  return sgt[li] * gelu_f(sut[li] * shl * r);
}
DEVFN void gather4_v(const RowBatch& B, float cf, f32x2 (&acc)[NTW][2 * EW]) {
#pragma unroll
  for (int j = 0; j < RB; ++j) axpy_row(B.w[j], bcast_lane(cf, 32 * ((j >> 2) & 1) + 16 * ((j >> 1) & 1) + 8 * (j & 1)), acc[j % NTW]);
}
DEVFN void ph_gather4(float* hio, const float* __restrict__ gn, const int* __restrict__ idx, const float* __restrict__ gate,
                      const unsigned char* __restrict__ ut, const unsigned char* __restrict__ vt, const float* __restrict__ su, const float* __restrict__ sv,
                      bf16_t* __restrict__ hb, float* __restrict__ rinv_next, const float* __restrict__ gfinal, char* smem, const XcdBarrier& xb, int which) {
  const int lane = TIDX & 63;
  XcdPace pc = xcd_pace_init(xb, which);
  static_assert(UPM == 12 && NSEL / 2 >= 16, "stagger assumes a pacing interval of 16 batches");
  const int pstag = uni_i(TIDX >> 6) >= NWV / 2 ? 8 : 0;
  int* srt = (int*)(smem + uni_i(TIDX >> 6) * (4 * NENT * 4));
  float* sgt = (float*)(srt + NENT);
  float* coefl = (float*)(srt + 2 * NENT);
  float* sut = (float*)(srt + 3 * NENT);
  const int jr = ((lane >> 5) & 1) * 4 + ((lane >> 4) & 1) * 2 + ((lane >> 3) & 1);
  constexpr int NGRP = T / NTW;
  const int g_iters = (NGRP + gridDim.x * NWV - 1) / (gridDim.x * NWV);
  for (int g_it = 0; g_it < g_iters; ++g_it) {
    const int g_raw = (g_it * gridDim.x + blockIdx.x) * NWV + uni_i(TIDX >> 6);
    const bool g_act = g_raw < NGRP;
    const int t0 = (g_act ? g_raw : NGRP - 1) * NTW;
    int hq[NTW][EW];
    float ri[NTW], sh[NTW];
#pragma unroll
    for (int k = 0; k < NTW; ++k) {
      f32x4 hv[EW];
      float ss = 0.f;
#pragma unroll
      for (int q = 0; q < EW; ++q) { hv[q] = *(const f32x4*)(hio + (size_t)(t0 + k) * DM + lane * EPL + 4 * q); ss += hv[q].x * hv[q].x + hv[q].y * hv[q].y + hv[q].z * hv[q].z + hv[q].w * hv[q].w; }
      ss = wave_sum(ss);
      ri[k] = rsqrtf(ss * (1.0f / DM) + RMS_EPS);
      float mxh = 0.f;
#pragma unroll
      for (int q = 0; q < EW; ++q) {
        const f32x4 gv = *(const f32x4*)(gn + lane * EPL + 4 * q);
        hv[q] = f32x4{hv[q].x * ri[k] * gv.x, hv[q].y * ri[k] * gv.y, hv[q].z * ri[k] * gv.z, hv[q].w * ri[k] * gv.w};
        mxh = fmaxf(mxh, fmaxf(fmaxf(fabsf(hv[q].x), fabsf(hv[q].y)), fmaxf(fabsf(hv[q].z), fabsf(hv[q].w))));
      }
      mxh = row16_max(mxh);
      { float a = mxh, b = mxh; swap16(a, b); mxh = fmaxf(mxh, (threadIdx.x & 16) ? a : b); }
      mxh = fmaxf(fmaxf(mxh, partner32(mxh)), 1e-30f);
      sh[k] = mxh * (1.0f / 119.0f);
      const float qi = 119.0f / mxh;
#pragma unroll
      for (int g = 0; g < U4W; ++g) {
        const float e8[8] = {hv[2 * g].x, hv[2 * g].y, hv[2 * g].z, hv[2 * g].w, hv[2 * g + 1].x, hv[2 * g + 1].y, hv[2 * g + 1].z, hv[2 * g + 1].w};
        unsigned wh = 0u, wl = 0u;
#pragma unroll
        for (int i = 0; i < 8; ++i) {
          const int t = (int)rintf(e8[i] * qi);
          const int tl = ((t + 8) & 15) - 8, th = (t - tl) >> 4;
          wh |= ((unsigned)th & 15u) << (4 * i); wl |= ((unsigned)tl & 15u) << (4 * i);
        }
        hq[k][g] = (int)wh; hq[k][U4W + g] = (int)wl;
      }
    }
    const float shl = (jr % NTW) == 0 ? sh[0] : (jr % NTW) == 1 ? sh[1] : (jr % NTW) == 2 ? sh[2] : sh[3];
    {
      int ent[ENTR]; float gt[ENTR], sue[ENTR]; int pos[ENTR];
#pragma unroll
      for (int r = 0; r < ENTR; ++r) {
        const int e = r * 64 + lane, k = e / NSEL, sl = e % NSEL;
        const float rik = k == 0 ? ri[0] : k == 1 ? ri[1] : k == 2 ? ri[2] : ri[3];
        ent[r] = idx[(size_t)(t0 + k) * NSEL + sl];
        const float raw = gate[(size_t)(t0 + k) * NSEL + sl];
        const float ex = __expf(rik * (raw - row16_max(raw)));
        gt[r] = ex / row16_sum(ex) * sv[ent[r]]; pos[r] = 0;
        sue[r] = su[ent[r]];
      }
#pragma unroll
      for (int k = 0; k < NTW; ++k) {
        constexpr int dummy = 0; (void)dummy;
        const int r_lo = (k * NSEL) / 64, r_hi = ((k + 1) * NSEL + 63) / 64;
        int base = k * NSEL;
        for (int v = 0; v < (NEXP >> GSH); ++v) {
#pragma unroll
          for (int r = 0; r < ENTR; ++r) {
            if (r < r_lo || r >= r_hi) continue;
            const bool mine = ((r * 64 + lane) / NSEL == k) && (bucket_of(ent[r]) == v);
            const unsigned long long m = wave_ballot(mine);
            pos[r] = mine ? base + mbcnt64(m, lane) : pos[r];
            base += __builtin_popcountll(m);
          }
        }
      }
      WAVE_SYNC();
#pragma unroll
      for (int r = 0; r < ENTR; ++r) { srt[pos[r]] = ent[r]; sgt[pos[r]] = gt[r]; sut[pos[r]] = sue[r]; }
      WAVE_SYNC();
    }
    constexpr int NBQ = NSEL / 2;
    static_assert(NBQ % 4 == 0, "ring of four batches");
    f32x2 acc[NTW][2 * EW];
#pragma unroll
    for (int k = 0; k < NTW; ++k)
#pragma unroll
      for (int q = 0; q < 2 * EW; ++q) acc[k][q] = f32x2{0.f, 0.f};
    RowBatch A, B, C, D;
    auto ld = [&](RowBatch& X, int q) { gather4_load<true>(X, 2 * q, srt, lane, jr, ut, su, sv); };
    auto up = [&](const RowBatch& X, int q) { return gather4_u(X, 2 * q, hq, shl, sgt, sut, lane, jr); };
    auto vp = [&](const RowBatch& X, float cf) { gather4_v(X, cf, acc); };
    float cA, cB, cC, cD;
    ld(A, 0); ld(B, 1); ld(C, 2);
    cA = up(A, 0);
    for (int q = 0; q < NBQ - 4; q += 4) {
      if ((q & UPM) == pstag) xcd_pace(pc);
      ld(D, q + 3);
      cB = up(B, q + 1); vp(A, cA); ld(A, q + 4);
      cC = up(C, q + 2); vp(B, cB); ld(B, q + 5);
      cD = up(D, q + 3); vp(C, cC); ld(C, q + 6);
      cA = up(A, q + 4); vp(D, cD);
    }
    ld(D, NBQ - 1);
    cB = up(B, NBQ - 3); vp(A, cA);
    cC = up(C, NBQ - 2); vp(B, cB);
    cD = up(D, NBQ - 1); vp(C, cC);
    vp(D, cD);
#pragma unroll
    for (int k = 0; k < NTW; ++k) {
      const int t = t0 + k;
      float hn[EPL]; float ss = 0.f;
#pragma unroll
      for (int q = 0; q < EW; ++q) {
        const f32x4 hv = *(const f32x4*)(hio + (size_t)t * DM + lane * EPL + 4 * q);
        hn[4 * q] = hv.x + acc[k][2 * q].x; hn[4 * q + 1] = hv.y + acc[k][2 * q].y; hn[4 * q + 2] = hv.z + acc[k][2 * q + 1].x; hn[4 * q + 3] = hv.w + acc[k][2 * q + 1].y;
      }
#pragma unroll
      for (int i = 0; i < EPL; ++i) ss += hn[i] * hn[i];
      ss = wave_sum(ss);
      const float rn = rsqrtf(ss * (1.0f / DM) + RMS_EPS);
      if (!g_act) {
      } else if (gfinal) {
#pragma unroll
        for (int q = 0; q < EW; ++q) {
          const f32x4 gv = *(const f32x4*)(gfinal + lane * EPL + 4 * q);
          *(f32x4*)(hio + (size_t)t * DM + lane * EPL + 4 * q) = f32x4{hn[4 * q] * rn * gv.x, hn[4 * q + 1] * rn * gv.y, hn[4 * q + 2] * rn * gv.z, hn[4 * q + 3] * rn * gv.w};
        }
      } else {
#pragma unroll
        for (int q = 0; q < EW; ++q) {
          *(f32x4*)(hio + (size_t)t * DM + lane * EPL + 4 * q) = f32x4{hn[4 * q], hn[4 * q + 1], hn[4 * q + 2], hn[4 * q + 3]};
          *(u32x2*)(hb + (size_t)t * DM + lane * EPL + 4 * q) = u32x2{pack2(hn[4 * q], hn[4 * q + 1]), pack2(hn[4 * q + 2], hn[4 * q + 3])};
        }
        if (lane == 0) rinv_next[t] = rn;
      }
    }
  }
}

constexpr int GLDW = 128 + 8;
DEVFN void ph_gmlp(const Params& P, const float* __restrict__ rinv_v, char* smem) {
  bf16_t* sW = (bf16_t*)smem;
  bf16_t* sVT = sW + 128 * GLDW;
  const bf16_t* __restrict__ pb = P.pb; const float* __restrict__ vg = P.in[23]; const float* __restrict__ bs = P.in[25];
  constexpr int NITEM = (T / 128) * NH;
  const int iters = (NITEM + gridDim.x - 1) / gridDim.x;
  const int tid = TIDX, lane = tid & 63, wv = tid >> 6, half = lane >> 5;
  int h_lds = -1;
  for (int it = 0; it < iters; ++it) {
    const int item = it * gridDim.x + blockIdx.x;
    const bool act = item < NITEM;
    const int h = item % NH, tok0 = (item / NH) * 128;
    __syncthreads();
    if (act) {
      if (h != h_lds) {
        h_lds = h;
        for (int e = tid; e < 128 * 16; e += NT) {
          const int row = e >> 4, c8 = (e & 15) * 8;
          *(u32x4*)(sW + row * GLDW + c8) = *(const u32x4*)(P.wsb + ((size_t)h * 128 + row) * 128 + c8);
        }
      }
      for (int e = tid; e < 128 * 8; e += NT) {
        const int sidx = e >> 3, d0 = (e & 7) * 8;
        const u32x4 w = *(const u32x4*)(pb + (size_t)(tok0 + sidx) * ODD_IN + AW + h * 64 + d0);
        const float ri = rinv_v[tok0 + sidx];
        const unsigned ws4[4] = {w.x, w.y, w.z, w.w};
#pragma unroll
        for (int j = 0; j < 4; ++j) {
          sVT[(d0 + 2 * j) * GLDW + sidx] = f2bf(gelu_f(bflo(ws4[j])) * ri * vg[h * 64 + d0 + 2 * j]);
          sVT[(d0 + 2 * j + 1) * GLDW + sidx] = f2bf(gelu_f(bfhi(ws4[j])) * ri * vg[h * 64 + d0 + 2 * j + 1]);
        }
      }
    }
    __syncthreads();
    if (!act) continue;
    const int mt = wv >> 1, nt = wv & 1;
    f32x16 acc;
#pragma unroll
    for (int r = 0; r < 16; ++r) acc[r] = 0.f;
    for (int ks = 0; ks < 2 * (mt + 1); ++ks) {
      const bf16x8 fa = *(const bf16x8*)(sW + (mt * 32 + (lane & 31)) * GLDW + ks * 16 + 8 * half);
      const bf16x8 fb = *(const bf16x8*)(sVT + (nt * 32 + (lane & 31)) * GLDW + ks * 16 + 8 * half);
      acc = mfma32(fa, fb, acc);
    }
    const int d = nt * 32 + (lane & 31);
#pragma unroll
    for (int r = 0; r < 16; ++r) {
      const int t = mt * 32 + (r & 3) + 8 * (r >> 2) + 4 * half;
      const float y = acc[r] + bs[h * 128 + t];
      const float u = gelu_f(bf2f(pb[(size_t)(tok0 + t) * ODD_IN + h * 64 + d]));
      P.cb[(size_t)(tok0 + t) * DM + h * 64 + d] = f2bf(u * y);
    }
  }
}

constexpr float SB_EXIT = -40.0f;
constexpr int VLD = 40;
DEVFN void ph_sbattn(const Params& P, char* smem) {
  const int tid = TIDX, lane = tid & 63, wv = tid >> 6, half = lane >> 5, l31 = lane & 31;
  bf16_t* vtp = (bf16_t*)(smem + wv * (64 * VLD * 2));
  constexpr int NQB = SEQ / 32;
  const bf16_t* __restrict__ pb = P.pb;
  for (int item = blockIdx.x * NWV + wv; item < NB * NH * NQB; item += gridDim.x * NWV) {
    const int qb = item % NQB, h = (item / NQB) % NH, b = item / (NQB * NH);
    const size_t tokb = (size_t)b * SEQ;
    bf16x8 qf[4];
    {
      const bf16_t* qp = pb + (tokb + qb * 32 + l31) * ODD_IN + 2 * AW + h * 64 + 8 * half;
#pragma unroll
      for (int s = 0; s < 4; ++s) qf[s] = *(const bf16x8*)(qp + 16 * s);
    }
    f32x16 oacc[2];
#pragma unroll
    for (int n = 0; n < 2; ++n)
#pragma unroll
      for (int r = 0; r < 16; ++r) oacc[n][r] = 0.f;
    float R = 0.f;
    const int qpos = qb * 32 + l31;
    for (int kt = qb; kt >= 0; --kt) {
      bf16x8 kf[4];
      {
        const bf16_t* kp = pb + (tokb + kt * 32 + l31) * ODD_IN + 3 * AW + h * 64 + 8 * half;
#pragma unroll
        for (int s = 0; s < 4; ++s) kf[s] = *(const bf16x8*)(kp + 16 * s);
      }
      WAVE_SYNC();
#pragma unroll
      for (int i = 0; i < 4; ++i) {
        const int c = lane + 64 * i, key = c >> 3, d0 = (c & 7) * 8;
        const u32x4 w = *(const u32x4*)(pb + (tokb + kt * 32 + key) * ODD_IN + 4 * AW + h * 64 + d0);
        const int slot = (key & 16) + 8 * ((key >> 2) & 1) + 4 * ((key >> 3) & 1) + (key & 3);
        const unsigned ws4[4] = {w.x, w.y, w.z, w.w};
#pragma unroll
        for (int j = 0; j < 4; ++j) {
          vtp[(d0 + 2 * j) * VLD + slot] = (bf16_t)(ws4[j] & 0xffffu);
          vtp[(d0 + 2 * j + 1) * VLD + slot] = (bf16_t)(ws4[j] >> 16);
        }
      }
      WAVE_SYNC();
      f32x16 z;
#pragma unroll
      for (int r = 0; r < 16; ++r) z[r] = 0.f;
#pragma unroll
      for (int s = 0; s < 4; ++s) z = mfma32(kf[s], qf[s], z);
      float lp[16], la[16];
#pragma unroll
      for (int r = 0; r < 16; ++r) {
        const int kpos = kt * 32 + (r & 3) + 8 * (r >> 2) + 4 * half;
        const bool valid = kpos < qpos;
        const float zz = z[r] * 0.125f;
        const float sp = fmaxf(zz, 0.f) + __logf(1.0f + __expf(-fabsf(zz)));
        lp[r] = valid ? -sp : 0.f;
        la[r] = valid ? zz - sp : -1.0e30f;
      }
      float e[16], tot[4], pt[4];
#pragma unroll
      for (int c = 0; c < 4; ++c) {
        e[4 * c + 3] = 0.f; e[4 * c + 2] = lp[4 * c + 3]; e[4 * c + 1] = e[4 * c + 2] + lp[4 * c + 2]; e[4 * c] = e[4 * c + 1] + lp[4 * c + 1];
        tot[c] = e[4 * c] + lp[4 * c];
      }
#pragma unroll
      for (int c = 0; c < 4; ++c) pt[c] = partner32(tot[c]);
      float G[8];
      G[7] = 0.f;
#pragma unroll
      for (int g = 6; g >= 0; --g) {
        const int c = (g + 1) >> 1;
        const bool odd = (g + 1) & 1;
        const float tg = odd ? (half ? tot[c] : pt[c]) : (half ? pt[c] : tot[c]);
        G[g] = G[g + 1] + tg;
      }
      const float total = G[0] + (half ? pt[0] : tot[0]);
      float w[16];
#pragma unroll
      for (int r = 0; r < 16; ++r) {
        const int c = r >> 2;
        const float gown = half ? G[2 * c + 1] : G[2 * c];
        w[r] = __expf(la[r] + R + gown + e[r]);
      }
      R += total;
#pragma unroll
      for (int s = 0; s < 2; ++s) {
        bf16x8 fa;
#pragma unroll
        for (int j = 0; j < 8; ++j) fa[j] = (short)f2bf(w[8 * s + j]);
#pragma unroll
        for (int n = 0; n < 2; ++n) {
          const bf16x8 fb = *(const bf16x8*)(vtp + (n * 32 + l31) * VLD + 16 * s + 8 * half);
          oacc[n] = mfma32(fa, fb, oacc[n]);
        }
      }
      if (__all(R < SB_EXIT)) break;
    }
#pragma unroll
    for (int n = 0; n < 2; ++n)
#pragma unroll
      for (int r = 0; r < 16; ++r) {
        const int row = (r & 3) + 8 * (r >> 2) + 4 * half;
        P.cb[(tokb + qb * 32 + row) * DM + AW + h * 64 + n * 32 + l31] = f2bf(oacc[n][r]);
      }
  }
}

#ifdef HOST_EMU
int emu_stage = 0;
#define EMU_STOP(n) if (emu_stage == n) return
#else
#define EMU_STOP(n)
#endif
__global__ void __launch_bounds__(NT) fwd_megakernel(Params P) {
  DECL_SMEM(smem, SMEM_BYTES);
#ifdef HOST_EMU
  const XcdBarrier xb{0};
#endif
#ifndef HOST_EMU
  if (threadIdx.x == 0) *(u32x4*)(smem + SMEM_BYTES - 16) = u32x4{0u, 0u, 0u, 0u};
  __syncthreads();
  const XcdBarrier xb = xcd_barrier_post(P.bar, (volatile LAS unsigned*)(smem + SMEM_BYTES - 16));
#endif
  const float* x = P.in[0];
  ph_prep(P, smem);
  GRID_SYNC();
  GEMM_SCALE(P.hb, P.wt_in0, DM, EVEN_IN, P.rinv, P.pb);
  XSYNC();
  ph_s5_pass1(P);
  ph_conv(P);
  XSYNC();
  ph_s5_pass2(P);
  {
    const int tidx[4] = {19, 20, 31, 32};
#pragma unroll
    for (int i = 0; i < 4; ++i) { if ((i & 1) == 0) prep_tab_i4(P.in[tidx[i]], P.tabs[i], P.tscale[i]); else prep_tab_fp4(P.in[tidx[i]], P.tabs[i - 1], P.tscale[i]); }
  }
  XSYNC();
  ph_s5_pass3(P, smem);
  XSYNC();
  GEMM_GLU(P.ya, P.wt_glu, AW, AW, P.ya, P.in[12], P.cb);
  XSYNC();
  GEMM_RES(P.cb, P.wt_out0, DM, DM, x, P.hout, P.hb);
  XSYNC();
  EMU_STOP(1);
  GEMM_SCALE(P.hb, P.wt_q0, DM, QN, (const float*)nullptr, P.pb);
  XSYNC();
  ph_topk(P.pb, P.keys[0], P.keys[1], P.idx, P.gate, smem);
  XSYNC();
  ph_gather4(P.hout, P.in[15], P.idx, P.gate, P.tabs[0], P.tabs[1], P.tscale[0], P.tscale[1], P.hb, P.rinv2, nullptr, smem, xb, 0);
  XSYNC();
  EMU_STOP(2);
  GEMM_SCALE(P.hb, P.wt_in1, DM, ODD_IN, P.rinv2, P.pb);
  XSYNC();
  rowstat_v(P.pb, P.rinv);
  XSYNC();
  ph_gmlp(P, P.rinv, smem);
  __syncthreads();
  __syncthreads();
  ph_sbattn(P, smem);
  XSYNC();
  GEMM_RES(P.cb, P.wt_out1, DM, DM, P.hout, P.hout, P.hb);
  XSYNC();
  EMU_STOP(3);
  GEMM_SCALE(P.hb, P.wt_q1, DM, QN, (const float*)nullptr, P.pb);
  XSYNC();
  ph_topk(P.pb, P.keys[2], P.keys[3], P.idx, P.gate, smem);
  XSYNC();
  ph_gather4(P.hout, P.in[27], P.idx, P.gate, P.tabs[2], P.tabs[3], P.tscale[2], P.tscale[3], P.hb, P.rinv2, P.in[33], smem, xb, 1);
}

static inline size_t align_up(size_t x) { return (x + 255) & ~(size_t)255; }

extern "C" void kernel_launch(void* const* d_in, const int* in_sizes, int n_in, void* d_out, int out_size, void* d_ws, size_t ws_size, hipStream_t stream) {
  (void)in_sizes; (void)n_in; (void)out_size; (void)ws_size;
  Params P{};
  for (int i = 0; i < 34; ++i) P.in[i] = (const float*)d_in[i];
  P.hout = (float*)d_out;
  char* ws = (char*)d_ws; size_t off = 0;
  auto carve = [&](size_t bytes) { char* p = ws + off; off = align_up(off + bytes); return p; };
  P.wt_in0 = (bf16_t*)carve((size_t)EVEN_IN * DM * 2);
  P.wt_glu = (bf16_t*)carve((size_t)AW * AW * 2);
  P.wt_out0 = (bf16_t*)carve((size_t)DM * DM * 2);
  P.wt_q0 = (bf16_t*)carve((size_t)QN * DM * 2);
  P.wt_in1 = (bf16_t*)carve((size_t)ODD_IN * DM * 2);
  P.wt_out1 = (bf16_t*)carve((size_t)DM * DM * 2);
  P.wt_q1 = (bf16_t*)carve((size_t)QN * DM * 2);
  for (int i = 0; i < 4; ++i) P.keys[i] = (bf16_t*)carve((size_t)PH * NKEY * 128 * 2);
  for (int i = 0; i < 4; ++i) P.tabs[i] = (unsigned char*)carve((size_t)NEXP * DM);
  for (int i = 0; i < 4; ++i) P.tscale[i] = (float*)carve((size_t)NEXP * 4);
  P.hb = (bf16_t*)carve((size_t)T * DM * 2);
  P.pb = (bf16_t*)carve((size_t)T * ODD_IN * 2);
  P.cb = (bf16_t*)carve((size_t)T * DM * 2);
  P.idx = (int*)carve((size_t)T * NSEL * 4);
  P.gate = (float*)carve((size_t)T * NSEL * 4);
  if constexpr ((size_t)AW * 2 <= (size_t)NSEL * 8) P.ya = (bf16_t*)P.idx;
  else P.ya = (bf16_t*)carve((size_t)T * AW * 2);
  P.S = (float*)carve((size_t)NB * NCH * NG * 128 * 4);
  P.S2 = (float*)carve((size_t)NB * NCH * NG * 128 * 4);
  P.rinv = (float*)carve((size_t)T * 4);
  P.rinv2 = (float*)carve((size_t)T * 4);
  P.bar = (unsigned*)carve(XCD_BAR_WORDS * 4);
  P.wsb = (bf16_t*)carve((size_t)NH * 128 * 128 * 2);
  P.tb.ar = (float*)carve(NG * 64 * 4); P.tb.ai = (float*)carve(NG * 64 * 4); P.tb.aqr = (float*)carve(NG * 64 * 4); P.tb.aqi = (float*)carve(NG * 64 * 4);
  P.tb.a16r = (float*)carve(NG * 64 * 4); P.tb.a16i = (float*)carve(NG * 64 * 4);
  P.tb.bbT = (bf16_t*)carve((size_t)NG * 128 * 16 * 2); P.tb.cmP = (bf16_t*)carve((size_t)NG * 16 * CMK * 2);
#ifdef HOST_EMU
  if (off > ws_size) { fprintf(stderr, "ws too small: need %zu have %zu\n", off, ws_size); abort(); }
  emu::launch(dim3(getenv("EMU_GRID") ? atoi(getenv("EMU_GRID")) : 3), dim3(NT), [=]() { fwd_megakernel(P); }, true);
#else
  static int grid_blocks = 0;
  if (!grid_blocks) {
    int dev = 0, cus = 0, per_cu = 0;
    hipGetDevice(&dev);
    hipDeviceGetAttribute(&cus, hipDeviceAttributeMultiprocessorCount, dev);
    hipOccupancyMaxActiveBlocksPerMultiprocessor(&per_cu, fwd_megakernel, NT, 0);
    if (per_cu > 1) per_cu = 1;
    grid_blocks = cus * per_cu;
  }
  (void)hipMemsetAsync(P.bar, 0, XCD_BAR_WORDS * 4, stream);
  void* args[] = {&P};
  hipError_t e = hipLaunchCooperativeKernel((void*)fwd_megakernel, dim3(grid_blocks), dim3(NT), args, 0, stream);
  if (e != hipSuccess) fprintf(stderr, "cooperative launch failed: %s (grid %d)\n", hipGetErrorString(e), grid_blocks);
#endif
}
```

```cpp
#ifndef HOST_EMU
#include <hip/hip_runtime.h>
#include <hip/hip_cooperative_groups.h>
#include <cstdio>
#define DECL_SMEM(name, bytes) __shared__ __attribute__((aligned(16))) char name[bytes]
#define GRID_SYNC() cooperative_groups::this_grid().sync()
#define WAVE_SYNC() do { __builtin_amdgcn_fence(__ATOMIC_RELEASE, "wavefront"); __builtin_amdgcn_wave_barrier(); __builtin_amdgcn_fence(__ATOMIC_ACQUIRE, "wavefront"); } while (0)
#else
#define DECL_SMEM(name, bytes) char* name = emu::smem(bytes)
#define GRID_SYNC() emu_grid_sync()
#define WAVE_SYNC() emu::sync(emu::ST_WAVE)
#endif
#include <utility>
#define DEVFN __device__ __forceinline__
#ifndef HOST_EMU
#define OPAQUE(x) asm volatile("" : "+v"(x))
#else
#define OPAQUE(x) asm volatile("" : "+r"(x))
#endif

#ifndef CFG_DM
#define CFG_DM 1024
#define CFG_SEQ 16384
#define CFG_PH 8
#endif

typedef unsigned short bf16_t;
typedef short bf16x8 __attribute__((ext_vector_type(8)));
typedef float f32x16 __attribute__((ext_vector_type(16)));
typedef unsigned u32x4 __attribute__((ext_vector_type(4)));
typedef unsigned u32x2 __attribute__((ext_vector_type(2)));
typedef float f32x4 __attribute__((ext_vector_type(4)));

constexpr int DM = CFG_DM, SEQ = CFG_SEQ, NB = 2, T = NB * SEQ;
constexpr int AW = DM / 2;
constexpr int EVEN_IN = 4 * AW, ODD_IN = 5 * AW;
constexpr int NG = AW / 16, NST = 64;
constexpr int NH = AW / 64;
constexpr int PH = CFG_PH, QN = PH * 256;
constexpr int NKEY = 128, NEXP = NKEY * NKEY, TOPK = 16, NSEL = PH * TOPK;
constexpr int SQ = 64, NCH = SEQ / SQ;
constexpr float RMS_EPS = 1e-6f;

DEVFN float bf2f(bf16_t h) { return __builtin_bit_cast(float, (unsigned)h << 16); }
DEVFN bf16_t f2bf(float f) { unsigned u = __builtin_bit_cast(unsigned, f); u += 0x7fffu + ((u >> 16) & 1u); return (bf16_t)(u >> 16); }
DEVFN float bflo(unsigned w) { return __builtin_bit_cast(float, w << 16); }
DEVFN float bfhi(unsigned w) { return __builtin_bit_cast(float, w & 0xffff0000u); }
DEVFN unsigned pack2(float lo, float hi) { return (unsigned)f2bf(lo) | ((unsigned)f2bf(hi) << 16); }
DEVFN float sigmoid_f(float x) { return 1.0f / (1.0f + __expf(-x)); }
DEVFN float gelu_f(float x) { float u = 1.5957691216057308f * (x + 0.044715f * x * x * x); return x / (1.0f + __expf(-u)); }
DEVFN void swap32(float& a, float& b) {
#ifndef HOST_EMU
  asm volatile("v_nop\n\tv_nop\n\tv_permlane32_swap_b32 %0, %1" : "+v"(a), "+v"(b));
#else
  const int lane = emu::cur % 64; const float xa = __shfl(a, lane ^ 32), xb = __shfl(b, lane ^ 32);
  if (lane < 32) b = xa; else a = xb;
#endif
}
DEVFN void swap16(float& a, float& b) {
#ifndef HOST_EMU
  asm volatile("v_nop\n\tv_nop\n\tv_permlane16_swap_b32 %0, %1" : "+v"(a), "+v"(b));
#else
  const int lane = emu::cur % 64; const float xa = __shfl(a, lane ^ 16), xb = __shfl(b, lane ^ 16);
  if ((lane & 16) == 0) b = xa; else a = xb;
#endif
}
template <int CTRL> DEVFN float dpp_f(float v) {
#ifndef HOST_EMU
  return __builtin_bit_cast(float, __builtin_amdgcn_update_dpp(0, __builtin_bit_cast(int, v), CTRL, 0xf, 0xf, true));
#else
  const int lane = emu::cur % 64;
  const int srcl = CTRL == 0x128 ? (lane ^ 8) : CTRL == 0x141 ? ((lane & ~7) | (7 - (lane & 7))) : CTRL == 0xB1 ? (lane ^ 1) : (lane ^ 2);
  return __shfl(v, srcl);
#endif
}

DEVFN float partner32(float v) { float a = v, b = v; swap32(a, b); return (threadIdx.x & 32) ? a : b; }
DEVFN float row16_sum(float v) { v += dpp_f<0xB1>(v); v += dpp_f<0x4E>(v); v += dpp_f<0x141>(v); v += dpp_f<0x128>(v); return v; }
DEVFN float row16_max(float v) { v = fmaxf(v, dpp_f<0xB1>(v)); v = fmaxf(v, dpp_f<0x4E>(v)); v = fmaxf(v, dpp_f<0x141>(v)); v = fmaxf(v, dpp_f<0x128>(v)); return v; }
DEVFN float wave_sum(float v) {
  v += dpp_f<0xB1>(v); v += dpp_f<0x4E>(v); v += dpp_f<0x141>(v); v += dpp_f<0x128>(v);
  { float a = v, b = v; swap16(a, b); v += (threadIdx.x & 16) ? a : b; }
  { float a = v, b = v; swap32(a, b); v += (threadIdx.x & 32) ? a : b; }
  return v;
}
DEVFN f32x16 mfma32(bf16x8 a, bf16x8 b, f32x16 c) {
#ifndef HOST_EMU
  return __builtin_amdgcn_mfma_f32_32x32x16_bf16(a, b, c, 0, 0, 0);
#else
  return emu_mfma32x32x16(a, b, c);
#endif
}


typedef float f32x2 __attribute__((ext_vector_type(2)));
#ifdef HOST_EMU
static inline unsigned emu_f2e4m3(float x) {
  unsigned s = (x < 0.f || (x == 0.f && std::signbit(x))) ? 0x80u : 0u; float a = fabsf(x);
  if (!(a == a)) return s | 0x7f;
  if (a >= 464.f) return s | 0x7e;
  if (a < 0.0009765625f) return s;
  int e; float m = frexpf(a, &e); e -= 1; m *= 2.f;
  if (e < -6) { float q = a * 512.f; float r = nearbyintf(q); unsigned mi = (unsigned)r; return s | mi; }
  float q = (m - 1.f) * 8.f; float r = nearbyintf(q); unsigned mi = (unsigned)r;
  if (mi == 8) { mi = 0; e += 1; }
  unsigned code = ((unsigned)(e + 7) << 3) | mi; if (code > 0x7e) code = 0x7e;
  return s | code;
}
static inline float emu_e4m32f(unsigned c) {
  float sgn = (c & 0x80) ? -1.f : 1.f; unsigned E = (c >> 3) & 15, m = c & 7;
  float v = E == 0 ? (m / 8.f) * 0.015625f : (1.f + m / 8.f) * ldexpf(1.f, (int)E - 7);
  return sgn * v;
}
#endif
DEVFN unsigned pack_fp8x4(float a, float b, float c, float d) {
#ifndef HOST_EMU
  int w = 0;
  w = __builtin_amdgcn_cvt_pk_fp8_f32(a, b, w, false);
  w = __builtin_amdgcn_cvt_pk_fp8_f32(c, d, w, true);
  return (unsigned)w;
#else
  return emu_f2e4m3(a) | (emu_f2e4m3(b) << 8) | (emu_f2e4m3(c) << 16) | (emu_f2e4m3(d) << 24);
#endif
}
DEVFN f32x2 unpack_fp8_lo(unsigned w) {
#ifndef HOST_EMU
  return __builtin_amdgcn_cvt_pk_f32_fp8((int)w, false);
#else
  return f32x2{emu_e4m32f(w & 255), emu_e4m32f((w >> 8) & 255)};
#endif
}
DEVFN f32x2 unpack_fp8_hi(unsigned w) {
#ifndef HOST_EMU
  return __builtin_amdgcn_cvt_pk_f32_fp8((int)w, true);
#else
  return f32x2{emu_e4m32f((w >> 16) & 255), emu_e4m32f(w >> 24)};
#endif
}

DEVFN int sdot4(int a, int b, int c) {
#ifndef HOST_EMU
  return __builtin_amdgcn_sdot4(a, b, c, false);
#else
  for (int i = 0; i < 4; ++i) c += (int)(signed char)(a >> (8 * i)) * (int)(signed char)(b >> (8 * i));
  return c;
#endif
}
DEVFN int sdot8(int a, int b, int c) {
#ifndef HOST_EMU
  return __builtin_amdgcn_sdot8(a, b, c, false);
#else
  for (int i = 0; i < 8; ++i) c += ((a << (28 - 4 * i)) >> 28) * ((b << (28 - 4 * i)) >> 28);
  return c;
#endif
}
DEVFN unsigned pack_i8x4(float a, float b, float c, float d) {
  return ((unsigned)(int)rintf(a) & 255u) | (((unsigned)(int)rintf(b) & 255u) << 8) | (((unsigned)(int)rintf(c) & 255u) << 16) | (((unsigned)(int)rintf(d) & 255u) << 24);
}
#ifdef HOST_EMU
static inline unsigned emu_f2e2m1(float x) {
  unsigned s = (x < 0.f || (x == 0.f && std::signbit(x))) ? 8u : 0u; float a = fabsf(x);
  static const float grid[8] = {0.f, 0.5f, 1.f, 1.5f, 2.f, 3.f, 4.f, 6.f};
  unsigned best = 0; float bd = 1e30f;
  for (unsigned i = 0; i < 8; ++i) { float d = fabsf(a - grid[i]); if (d < bd || (d == bd && (i & 1) == 0)) { bd = d; best = i; } }
  return s | best;
}
static inline float emu_e2m12f(unsigned c) { static const float grid[8] = {0.f, 0.5f, 1.f, 1.5f, 2.f, 3.f, 4.f, 6.f}; return ((c & 8) ? -1.f : 1.f) * grid[c & 7]; }
#endif
DEVFN unsigned pack_fp4x8(const float (&x)[8]) {
#ifndef HOST_EMU
  unsigned w = 0;
  w = __builtin_amdgcn_cvt_scalef32_pk_fp4_f32(w, x[0], x[1], 1.0f, 0);
  w = __builtin_amdgcn_cvt_scalef32_pk_fp4_f32(w, x[2], x[3], 1.0f, 1);
  w = __builtin_amdgcn_cvt_scalef32_pk_fp4_f32(w, x[4], x[5], 1.0f, 2);
  w = __builtin_amdgcn_cvt_scalef32_pk_fp4_f32(w, x[6], x[7], 1.0f, 3);
  return w;
#else
  unsigned w = 0;
  for (int i = 0; i < 8; ++i) w |= emu_f2e2m1(x[i]) << (4 * i);
  return w;
#endif
}
template <int BYTE> DEVFN f32x2 unpack_fp4(unsigned w) {
#ifndef HOST_EMU
  return __builtin_amdgcn_cvt_scalef32_pk_f32_fp4(w, 1.0f, BYTE);
#else
  return f32x2{emu_e2m12f((w >> (8 * BYTE)) & 15), emu_e2m12f((w >> (8 * BYTE + 4)) & 15)};
#endif
}
DEVFN float bcast_lane(float v, int srclane) {
#ifndef HOST_EMU
  return __builtin_bit_cast(float, __builtin_amdgcn_readlane(__builtin_bit_cast(int, v), srclane));
#else
  return __shfl(v, srclane);
#endif
}
DEVFN int bcast_lane_i(int v, int srclane) {
#ifndef HOST_EMU
  return __builtin_amdgcn_readlane(v, srclane);
#else
  return __shfl(v, srclane);
#endif
}

DEVFN int opaque_tid() { int t = threadIdx.x; OPAQUE(t); return t; }
#define TIDX opaque_tid()

DEVFN unsigned long long wave_ballot(bool p) {
#ifndef HOST_EMU
  return __builtin_amdgcn_ballot_w64(p);
#else
  return __ballot(p ? 1 : 0);
#endif
}
DEVFN int mbcnt64(unsigned long long m, int lane) {
#ifndef HOST_EMU
  return (int)__builtin_amdgcn_mbcnt_hi((unsigned)(m >> 32), __builtin_amdgcn_mbcnt_lo((unsigned)m, 0u));
#else
  return __builtin_popcountll(m & ((1ull << lane) - 1ull));
#endif
}


constexpr int NT = 512, NWV = NT / 64;
constexpr int SMEM_BYTES = 160 * 1024;

struct S5Tab { float* ar; float* ai; float* aqr; float* aqi; float* a16r; float* a16i; bf16_t* bbT; bf16_t* cmP; };
struct Params {
  const float* in[34];
  float* hout;
  bf16_t* wt_in0; bf16_t* wt_glu; bf16_t* wt_out0; bf16_t* wt_q0; bf16_t* wt_in1; bf16_t* wt_out1; bf16_t* wt_q1;
  bf16_t* keys[4]; unsigned char* tabs[4]; float* tscale[4];
  bf16_t* hb; bf16_t* pb; bf16_t* cb; bf16_t* ya;
  int* idx; float* gate;
  float* S; float* S2; float* rinv; float* rinv2;
  S5Tab tb;
  unsigned* bar;
  bf16_t* wsb;
};

DEVFN void prep_wt(const float* __restrict__ W, const float* __restrict__ g, bf16_t* __restrict__ Wt, int K, int N, char* smem) {
  const int sub = TIDX >> 8, stid = TIDX & 255;
  float* tile = (float*)(smem + sub * (64 * 65 * 4));
  const int ntn = N / 64, ntiles = (K / 64) * ntn;
  const int stride = gridDim.x * 2;
  const int iters = (ntiles + stride - 1) / stride;
  for (int it = 0; it < iters; ++it) {
    const int vb = (it * gridDim.x + blockIdx.x) * 2 + sub;
    const bool act = vb < ntiles;
    const int k0 = (vb / ntn) * 64, n0 = (vb % ntn) * 64;
    __syncthreads();
    if (act)
      for (int e = stid; e < 64 * 64; e += 256) {
        int i = e >> 6, j = e & 63;
        float gv = g ? g[k0 + i] : 1.0f;
        tile[i * 65 + j] = W[(size_t)(k0 + i) * N + n0 + j] * gv;
      }
    __syncthreads();
    if (act)
      for (int e = stid; e < 64 * 64; e += 256) {
        int j = e >> 6, i = e & 63;
        Wt[(size_t)(n0 + j) * K + k0 + i] = f2bf(tile[i * 65 + j]);
      }
  }
}
DEVFN void cvt_bf16(const float* __restrict__ src, bf16_t* __restrict__ dst, size_t n4) {
  for (size_t i = (size_t)blockIdx.x * NT + TIDX; i < n4; i += (size_t)gridDim.x * NT) {
    f32x4 v = ((const f32x4*)src)[i];
    ((u32x2*)dst)[i] = u32x2{pack2(v.x, v.y), pack2(v.z, v.w)};
  }
}
constexpr int CMK = 144;
DEVFN void prep_s5(const Params& P) {
  for (int gid = blockIdx.x * NT + TIDX; gid < NG * NST; gid += gridDim.x * NT) {
  const int gp = gid, g = gid / NST, p = gid % NST;
  const float* lam_re = P.in[3]; const float* lam_im = P.in[4]; const float* log_dt = P.in[5];
  const float* b_re = P.in[6]; const float* b_im = P.in[7];
  const float* c_re = P.in[8]; const float* c_im = P.in[9]; const float* dsk = P.in[10];
  const S5Tab& tb = P.tb;
  const float dt = __expf(log_dt[g]);
  const float lr = lam_re[gp], li = lam_im[gp];
  const float mag = __expf(lr * dt);
  const float ar = mag * cosf(li * dt), ai = mag * sinf(li * dt);
  const float den = lr * lr + li * li;
  const float nr = ar - 1.0f;
  const float fr = (nr * lr + ai * li) / den, fi = (ai * lr - nr * li) / den;
  tb.ar[gp] = ar; tb.ai[gp] = ai;
  float qr = ar, qi = ai;
#pragma unroll
  for (int sq = 0; sq < 6; ++sq) {
    float nr2 = qr * qr - qi * qi, ni2 = 2.0f * qr * qi; qr = nr2; qi = ni2;
    if (sq == 3) { tb.a16r[gp] = qr; tb.a16i[gp] = qi; }
  }
  tb.aqr[gp] = qr; tb.aqi[gp] = qi;
  const int c = p & 31, hi = p >> 5;
  for (int ci = 0; ci < 16; ++ci) {
    const float br = b_re[gp * 16 + ci], bi = b_im[gp * 16 + ci];
    tb.bbT[((size_t)g * 128 + (0 + hi) * 32 + c) * 16 + ci] = f2bf(fr * br - fi * bi);
    tb.bbT[((size_t)g * 128 + (2 + hi) * 32 + c) * 16 + ci] = f2bf(fr * bi + fi * br);
  }
  for (int co = 0; co < 16; ++co) {
    tb.cmP[((size_t)g * 16 + co) * CMK + 4 * c + 2 * hi + 0] = f2bf(c_re[((size_t)g * 16 + co) * NST + p]);
    tb.cmP[((size_t)g * 16 + co) * CMK + 4 * c + 2 * hi + 1] = f2bf(-c_im[((size_t)g * 16 + co) * NST + p]);
    if (p < 16) tb.cmP[((size_t)g * 16 + co) * CMK + 128 + p] = (p == co) ? f2bf(dsk[g * 16 + co]) : (bf16_t)0;
  }
  }
}
DEVFN void rowstat(const float* __restrict__ h, float* __restrict__ rinv, bf16_t* __restrict__ hb) {
  const int lane = TIDX & 63;
  for (int t = blockIdx.x * NWV + (TIDX >> 6); t < T; t += gridDim.x * NWV) {
    const float* row = h + (size_t)t * DM;
    float ss = 0.f;
#pragma unroll
    for (int i = 0; i < DM / 256; ++i) {
      f32x4 v = ((const f32x4*)row)[i * 64 + lane];
      ss += v.x * v.x + v.y * v.y + v.z * v.z + v.w * v.w;
      if (hb) ((u32x2*)(hb + (size_t)t * DM))[i * 64 + lane] = u32x2{pack2(v.x, v.y), pack2(v.z, v.w)};
    }
    ss = wave_sum(ss);
    if (lane == 0) rinv[t] = rsqrtf(ss * (1.0f / DM) + RMS_EPS);
  }
}
DEVFN void rowstat_v(const bf16_t* __restrict__ pb, float* __restrict__ rinv_v) {
  const int lane = TIDX & 63;
  for (int t = blockIdx.x * NWV + (TIDX >> 6); t < T; t += gridDim.x * NWV) {
    const bf16_t* row = pb + (size_t)t * ODD_IN + AW;
    float ss = 0.f;
    for (int c = lane; c < AW; c += 64) { float v = gelu_f(bf2f(row[c])); ss += v * v; }
    ss = wave_sum(ss);
    if (lane == 0) rinv_v[t] = rsqrtf(ss * (1.0f / AW) + RMS_EPS);
  }
}
constexpr int EPL = DM / 64;
constexpr int EW = EPL / 4;
DEVFN void prep_tab_fp8(const float* __restrict__ src, unsigned char* __restrict__ dst, float* __restrict__ scale) {
  const int lane = TIDX & 63;
  for (int r = blockIdx.x * NWV + (TIDX >> 6); r < NEXP; r += gridDim.x * NWV) {
    float v[EPL];
#pragma unroll
    for (int k = 0; k < EW; ++k) { f32x4 x = *(const f32x4*)(src + (size_t)r * DM + lane * EPL + 4 * k); v[4 * k] = x.x; v[4 * k + 1] = x.y; v[4 * k + 2] = x.z; v[4 * k + 3] = x.w; }
    float mx = 0.f;
#pragma unroll
    for (int i = 0; i < EPL; ++i) mx = fmaxf(mx, fabsf(v[i]));
    mx = row16_max(mx);
    { float a = mx, b = mx; swap16(a, b); mx = fmaxf(mx, (threadIdx.x & 16) ? a : b); }
    mx = fmaxf(mx, partner32(mx));
    mx = fmaxf(mx, 1e-30f);
    const float inv = 224.0f / mx;
    unsigned w[EW];
#pragma unroll
    for (int k = 0; k < EW; ++k) w[k] = pack_fp8x4(v[4 * k] * inv, v[4 * k + 1] * inv, v[4 * k + 2] * inv, v[4 * k + 3] * inv);
    if constexpr (EW == 4) *(u32x4*)(dst + (size_t)r * DM + lane * EPL) = u32x4{w[0], w[1], w[2], w[3]};
    else *(u32x2*)(dst + (size_t)r * DM + lane * EPL) = u32x2{w[0], w[1]};
    if (lane == 0) scale[r] = mx * (1.0f / 224.0f);
  }
}
DEVFN void prep_tab_i8(const float* __restrict__ src, unsigned char* __restrict__ dst, float* __restrict__ scale) {
  const int lane = TIDX & 63;
  for (int r = blockIdx.x * NWV + (TIDX >> 6); r < NEXP; r += gridDim.x * NWV) {
    float v[EPL];
#pragma unroll
    for (int k = 0; k < EW; ++k) { f32x4 x = *(const f32x4*)(src + (size_t)r * DM + lane * EPL + 4 * k); v[4 * k] = x.x; v[4 * k + 1] = x.y; v[4 * k + 2] = x.z; v[4 * k + 3] = x.w; }
    float mx = 0.f;
#pragma unroll
    for (int i = 0; i < EPL; ++i) mx = fmaxf(mx, fabsf(v[i]));
    mx = row16_max(mx);
    { float a = mx, b = mx; swap16(a, b); mx = fmaxf(mx, (threadIdx.x & 16) ? a : b); }
    mx = fmaxf(mx, partner32(mx));
    mx = fmaxf(mx, 1e-30f);
    const float inv = 127.0f / mx;
    unsigned w[EW];
#pragma unroll
    for (int k = 0; k < EW; ++k) w[k] = pack_i8x4(v[4 * k] * inv, v[4 * k + 1] * inv, v[4 * k + 2] * inv, v[4 * k + 3] * inv);
    if constexpr (EW == 4) *(u32x4*)(dst + (size_t)r * DM + lane * EPL) = u32x4{w[0], w[1], w[2], w[3]};
    else *(u32x2*)(dst + (size_t)r * DM + lane * EPL) = u32x2{w[0], w[1]};
    if (lane == 0) scale[r] = mx * (1.0f / 127.0f);
  }
}
constexpr int U4W = EW / 2;
static_assert(EW % 2 == 0, "int4 u rows need EPL to be a multiple of 8");
DEVFN void prep_tab_i4(const float* __restrict__ src, unsigned char* __restrict__ dst, float* __restrict__ scale) {
  const int lane = TIDX & 63;
  for (int r = blockIdx.x * NWV + (TIDX >> 6); r < NEXP; r += gridDim.x * NWV) {
    float v[EPL];
#pragma unroll
    for (int k = 0; k < EW; ++k) { f32x4 x = *(const f32x4*)(src + (size_t)r * DM + lane * EPL + 4 * k); v[4 * k] = x.x; v[4 * k + 1] = x.y; v[4 * k + 2] = x.z; v[4 * k + 3] = x.w; }
    float mx = 0.f;
#pragma unroll
    for (int i = 0; i < EPL; ++i) mx = fmaxf(mx, fabsf(v[i]));
    mx = row16_max(mx);
    { float a = mx, b = mx; swap16(a, b); mx = fmaxf(mx, (threadIdx.x & 16) ? a : b); }
    mx = fmaxf(mx, partner32(mx));
    mx = fmaxf(mx, 1e-30f);
    const float inv = 7.0f / mx;
    unsigned w[U4W];
#pragma unroll
    for (int g = 0; g < U4W; ++g) {
      w[g] = 0u;
#pragma unroll
      for (int k = 0; k < 8; ++k) w[g] |= ((unsigned)(int)rintf(v[8 * g + k] * inv) & 15u) << (4 * k);
    }
    if constexpr (U4W == 2) *(u32x2*)(dst + (size_t)r * DM + lane * EPL) = u32x2{w[0], w[1]};
    else *(unsigned*)(dst + (size_t)r * DM + lane * EPL) = w[0];
    if (lane == 0) scale[r] = mx * (1.0f / 7.0f);
  }
}
DEVFN void prep_tab_fp4(const float* __restrict__ src, unsigned char* __restrict__ dst, float* __restrict__ scale) {
  const int lane = TIDX & 63;
  for (int r = blockIdx.x * NWV + (TIDX >> 6); r < NEXP; r += gridDim.x * NWV) {
    float v[EPL];
#pragma unroll
    for (int k = 0; k < EW; ++k) { f32x4 x = *(const f32x4*)(src + (size_t)r * DM + lane * EPL + 4 * k); v[4 * k] = x.x; v[4 * k + 1] = x.y; v[4 * k + 2] = x.z; v[4 * k + 3] = x.w; }
    float mx = 0.f;
#pragma unroll
    for (int i = 0; i < EPL; ++i) mx = fmaxf(mx, fabsf(v[i]));
    mx = row16_max(mx);
    { float a = mx, b = mx; swap16(a, b); mx = fmaxf(mx, (threadIdx.x & 16) ? a : b); }
    mx = fmaxf(mx, partner32(mx));
    mx = fmaxf(mx, 1e-30f);
    const float inv = 6.0f / mx;
    unsigned w[U4W];
#pragma unroll
    for (int g = 0; g < U4W; ++g) {
      float a[8];
#pragma unroll
      for (int i = 0; i < 8; ++i) a[i] = v[8 * g + i] * inv;
      w[g] = pack_fp4x8(a);
    }
    if constexpr (U4W == 2) *(u32x2*)(dst + (size_t)r * DM + lane * EPL + EPL / 2) = u32x2{w[0], w[1]};
    else *(unsigned*)(dst + (size_t)r * DM + lane * EPL + EPL / 2) = w[0];
    if (lane == 0) scale[r] = mx * (1.0f / 6.0f);
  }
}
DEVFN void ph_prep(const Params& P, char* smem) {
  prep_wt(P.in[2], P.in[1], P.wt_in0, DM, EVEN_IN, smem);
  prep_wt(P.in[11], nullptr, P.wt_glu, AW, AW, smem);
  prep_wt(P.in[14], nullptr, P.wt_out0, DM, DM, smem);
  prep_wt(P.in[16], P.in[15], P.wt_q0, DM, QN, smem);
  prep_wt(P.in[22], P.in[21], P.wt_in1, DM, ODD_IN, smem);
  prep_wt(P.in[26], nullptr, P.wt_out1, DM, DM, smem);
  prep_wt(P.in[28], P.in[27], P.wt_q1, DM, QN, smem);
  const int kidx[4] = {17, 18, 29, 30};
#pragma unroll
  for (int i = 0; i < 4; ++i) cvt_bf16(P.in[kidx[i]], P.keys[i], (size_t)PH * NKEY * 128 / 4);
  prep_s5(P);
  for (int e = blockIdx.x * NT + TIDX; e < NH * 128 * 128; e += gridDim.x * NT) {
    const int t = (e >> 7) & 127, sidx = e & 127;
    P.wsb[e] = sidx <= t ? f2bf(P.in[24][e]) : (bf16_t)0;
  }
  rowstat(P.in[0], P.rinv, P.hb);
}

constexpr int GBK = 64, GLD = GBK + 8;
constexpr int GEMM_SMEM = 2 * 128 * GLD * 2;
template <class Epi>
DEVFN void gemm_tile_128(const bf16_t* __restrict__ A, int lda, const bf16_t* __restrict__ Wt, int K, int m0, int n0, char* sm, int tid, bool act, Epi& epi) {
  bf16_t* sA = (bf16_t*)sm;
  bf16_t* sB = sA + 128 * GLD;
  const int lane = tid & 63, wid = tid >> 6;
  const int wm = (wid >> 1) * 64, wn = (wid & 1) * 64;
  const int lr = tid >> 3, lc = (tid & 7) * 8;
  f32x16 acc[2][2];
#pragma unroll
  for (int i = 0; i < 2; ++i)
#pragma unroll
    for (int j = 0; j < 2; ++j)
#pragma unroll
      for (int r = 0; r < 16; ++r) acc[i][j][r] = 0.f;
  u32x4 ra[4], rb[4];
#pragma unroll
  for (int p = 0; p < 4; ++p) {
    ra[p] = *(const u32x4*)(A + (size_t)(m0 + lr + 32 * p) * lda + lc);
    rb[p] = *(const u32x4*)(Wt + (size_t)(n0 + lr + 32 * p) * K + lc);
  }
  for (int k0 = 0; k0 < K; k0 += GBK) {
    __syncthreads();
#pragma unroll
    for (int p = 0; p < 4; ++p) {
      *(u32x4*)(sA + (lr + 32 * p) * GLD + lc) = ra[p];
      *(u32x4*)(sB + (lr + 32 * p) * GLD + lc) = rb[p];
    }
    __syncthreads();
    {
      const int kn = (k0 + GBK < K) ? (k0 + GBK) : k0;
#pragma unroll
      for (int p = 0; p < 4; ++p) {
        ra[p] = *(const u32x4*)(A + (size_t)(m0 + lr + 32 * p) * lda + kn + lc);
        rb[p] = *(const u32x4*)(Wt + (size_t)(n0 + lr + 32 * p) * K + kn + lc);
      }
    }
#pragma unroll
    for (int kk = 0; kk < GBK; kk += 16) {
      bf16x8 fa[2], fb[2];
#pragma unroll
      for (int i = 0; i < 2; ++i) fa[i] = *(const bf16x8*)(sA + (wm + 32 * i + (lane & 31)) * GLD + kk + 8 * (lane >> 5));
#pragma unroll
      for (int j = 0; j < 2; ++j) fb[j] = *(const bf16x8*)(sB + (wn + 32 * j + (lane & 31)) * GLD + kk + 8 * (lane >> 5));
#pragma unroll
      for (int i = 0; i < 2; ++i)
#pragma unroll
        for (int j = 0; j < 2; ++j) acc[i][j] = mfma32(fa[i], fb[j], acc[i][j]);
    }
  }
  if (act) {
#pragma unroll
    for (int i = 0; i < 2; ++i)
#pragma unroll
      for (int j = 0; j < 2; ++j)
#pragma unroll
        for (int r = 0; r < 16; ++r) {
          int row = m0 + wm + 32 * i + (r & 3) + 8 * (r >> 2) + 4 * (lane >> 5);
          int col = n0 + wn + 32 * j + (lane & 31);
          epi(row, col, acc[i][j][r]);
        }
  }
}
struct EpiScaleBf16 {
  const float* rinv; bf16_t* out; int ldo;
  DEVFN void operator()(int row, int col, float v) { out[(size_t)row * ldo + col] = f2bf(rinv ? v * rinv[row] : v); }
};
struct EpiGlu {
  const bf16_t* ypre; const float* bias; bf16_t* out;
  DEVFN void operator()(int row, int col, float v) {
    float y = bf2f(ypre[(size_t)row * AW + col]);
    out[(size_t)row * DM + col] = f2bf(y * sigmoid_f(v + bias[col]));
  }
};
struct EpiResidual {
  const float* hin; float* hout; bf16_t* hb;
  DEVFN void operator()(int row, int col, float v) {
    size_t o = (size_t)row * DM + col;
    float h = hin[o] + v; hout[o] = h; hb[o] = f2bf(h);
  }
};
template <class Epi>
DEVFN void ph_gemm(const bf16_t* __restrict__ A, int lda, const bf16_t* __restrict__ Wt, int K, int N, Epi epi, char* smem) {
  const int sub = TIDX >> 8, stid = TIDX & 255;
  const int ntn = N / 128, ntiles = (T / 128) * ntn;
  const int stride = gridDim.x * 2;
  const int iters = (ntiles + stride - 1) / stride;
  for (int it = 0; it < iters; ++it) {
    int vb = (it * gridDim.x + blockIdx.x) * 2 + sub;
    const bool act = vb < ntiles;
    if (!act) vb = ntiles - 1;
    gemm_tile_128(A, lda, Wt, K, (vb / ntn) * 128, (vb % ntn) * 128, smem + sub * GEMM_SMEM, stid, act, epi);
  }
}


#ifndef HOST_EMU
namespace pg8 {
#define PG8_LAS __attribute__((address_space(3)))
constexpr int BM = 256, BK = 64, HALF = 128, HTB = HALF * BK * 2  , STAGE_BYTES = 8 * HTB, NXCD = 8, WGM = 8;
__host__ __device__ __forceinline__ int lds_byte(int r, int c) { const int st = (r >> 4) * 2 + (c >> 5), rr = r & 15, cc = c & 31, ob = rr * 64 + cc * 2; return st * 1024 + (ob ^ (((ob >> 9) & 1) << 5)); }
__host__ __device__ __forceinline__ void stage_rc(int b, int& R, int& C) { const int st = b / 1024, sb = b % 1024, swz = sb ^ (((sb >> 9) & 1) << 5); R = (st >> 1) * 16 + swz / 64; C = (st & 1) * 32 + (swz % 64) / 2; }
__host__ __device__ __forceinline__ int perm32(int rho) { const int n = rho >> 4, i = rho & 15; return 8 * (i >> 2) + 4 * n + (i & 3); }
struct Unit { int pm, pn; };
struct Gemm { const bf16_t* A; const bf16_t* Bt; int M, N, K; };
struct StaticOrder {
    int nM, nN, nwg, G, c;
    __host__ __device__ void init(int M, int N, int G_, int c_) { nM = M / BM; nN = N / BM; nwg = nM * nN; G = G_; c = c_; }
    __host__ __device__ bool next(int i, Unit& u) const {
        const long L = (long)i * G + c; if (L >= nwg) return false;
        int wgid = (int)L; { const int q = nwg / NXCD, r = nwg % NXCD, xcd = wgid % NXCD, off = wgid / NXCD; wgid = (xcd < r ? xcd * (q + 1) : r * (q + 1) + (xcd - r) * q) + off; }
        const int nig = WGM * nN, gid = wgid / nig, fm = gid * WGM, gsz = (nM - fm) < WGM ? (nM - fm) : WGM;
        u.pm = fm + ((wgid % nig) % gsz); u.pn = (wgid % nig) / gsz; return true;
    }
    __device__ __forceinline__ void a_ready(const Unit&) const {}
    __device__ __forceinline__ void done(const Unit&) const {}
};
__device__ __forceinline__ unsigned cvt_pk_bf16(float lo, float hi) { unsigned r; asm volatile("v_cvt_pk_bf16_f32 %0, %1, %2" : "=v"(r) : "v"(lo), "v"(hi)); return r; }
struct PEpiScaleBf16 {
    static constexpr bool PERM = true, AFTER_DRAIN = false;
    const float* rinv; bf16_t* out; int ldo;
    __device__ __forceinline__ void operator()(const f32x4 (&acc)[2][2][4][2], const Unit& u, int wr, int wc, int fr, int fq) const {
        const int row0 = u.pm * BM + wr * 64 + fr, col0 = u.pn * BM + wc * 32 + 8 * fq;
#pragma unroll
        for (int ai = 0; ai < 2; ++ai)
#pragma unroll
            for (int m = 0; m < 4; ++m) { const int row = row0 + ai * HALF + m * 16; const float sc = rinv ? rinv[row] : 1.0f; bf16_t* rowp = out + (size_t)row * ldo + col0;
#pragma unroll
                for (int bj = 0; bj < 2; ++bj) { const f32x4 v0 = acc[ai][bj][m][0] * sc, v1 = acc[ai][bj][m][1] * sc;
                    u32x4 w; w.x = cvt_pk_bf16(v0[0], v0[1]); w.y = cvt_pk_bf16(v0[2], v0[3]); w.z = cvt_pk_bf16(v1[0], v1[1]); w.w = cvt_pk_bf16(v1[2], v1[3]);
                    *(u32x4*)(rowp + bj * HALF) = w; } }
    }
};
struct PEpiGlu {
    static constexpr bool PERM = true, AFTER_DRAIN = false;
    const bf16_t* ypre; const float* bias; bf16_t* out;
    __device__ __forceinline__ void operator()(const f32x4 (&acc)[2][2][4][2], const Unit& u, int wr, int wc, int fr, int fq) const {
        const int row0 = u.pm * BM + wr * 64 + fr, col0 = u.pn * BM + wc * 32 + 8 * fq;
#pragma unroll
        for (int ai = 0; ai < 2; ++ai)
#pragma unroll
            for (int m = 0; m < 4; ++m) { const int row = row0 + ai * HALF + m * 16;
#pragma unroll
                for (int bj = 0; bj < 2; ++bj) { const int col = col0 + bj * HALF;
                    const f32x4 b0 = *(const f32x4*)(bias + col), b1 = *(const f32x4*)(bias + col + 4);
                    const u32x4 yp = *(const u32x4*)(ypre + (size_t)row * AW + col);
                    const f32x4 g0 = acc[ai][bj][m][0] + b0, g1 = acc[ai][bj][m][1] + b1;
                    u32x4 w;
                    w.x = cvt_pk_bf16(bflo(yp.x) * sigmoid_f(g0[0]), bfhi(yp.x) * sigmoid_f(g0[1])); w.y = cvt_pk_bf16(bflo(yp.y) * sigmoid_f(g0[2]), bfhi(yp.y) * sigmoid_f(g0[3]));
                    w.z = cvt_pk_bf16(bflo(yp.z) * sigmoid_f(g1[0]), bfhi(yp.z) * sigmoid_f(g1[1])); w.w = cvt_pk_bf16(bflo(yp.w) * sigmoid_f(g1[2]), bfhi(yp.w) * sigmoid_f(g1[3]));
                    *(u32x4*)(out + (size_t)row * DM + col) = w; } }
    }
};
struct PEpiResidual {
    static constexpr bool PERM = true, AFTER_DRAIN = false;
    const float* hin; float* hout; bf16_t* hb;
    __device__ __forceinline__ void operator()(const f32x4 (&acc)[2][2][4][2], const Unit& u, int wr, int wc, int fr, int fq) const {
        const int row0 = u.pm * BM + wr * 64 + fr, col0 = u.pn * BM + wc * 32 + 8 * fq;
#pragma unroll
        for (int ai = 0; ai < 2; ++ai)
#pragma unroll
            for (int m = 0; m < 4; ++m) { const int row = row0 + ai * HALF + m * 16;
#pragma unroll
                for (int bj = 0; bj < 2; ++bj) { const size_t o = (size_t)row * DM + col0 + bj * HALF;
                    const f32x4 v0 = *(const f32x4*)(hin + o) + acc[ai][bj][m][0], v1 = *(const f32x4*)(hin + o + 4) + acc[ai][bj][m][1];
                    *(f32x4*)(hout + o) = v0; *(f32x4*)(hout + o + 4) = v1;
                    u32x4 w; w.x = cvt_pk_bf16(v0[0], v0[1]); w.y = cvt_pk_bf16(v0[2], v0[3]); w.z = cvt_pk_bf16(v1[0], v1[1]); w.w = cvt_pk_bf16(v1[2], v1[3]);
                    *(u32x4*)(hb + o) = w; } }
    }
};
template <class Epi, class Sched>
__device__ __forceinline__ void gemm_phase(PG8_LAS unsigned char* lds, const Gemm g, const Sched& S, const Epi& E) {
    const int tid = opaque_tid(), wid = __builtin_amdgcn_readfirstlane(tid >> 6), lane = tid & 63, wr = wid >> 2, wc = wid & 3, fr = lane & 15, fq = lane >> 4;
    const int K = g.K, nt = K / BK;
    unsigned voffA[2], voffB[2];
#pragma unroll
    for (int i = 0; i < 2; ++i) { int R, C; stage_rc(tid * 16 + i * 8192, R, C); const int Rb = Epi::PERM ? ((R & ~31) + perm32(R & 31)) : R;
        voffA[i] = (unsigned)(R * K + C) * 2u; voffB[i] = (unsigned)(Rb * K + C) * 2u; }
    const size_t kstep = (size_t)(BK * 2);
    const size_t hstep = (size_t)HALF * K * 2;
    const size_t tstep = 2 * hstep;
    const unsigned ldsw = (unsigned)wid * 1024u;
    const int aoff = lds_byte(wr * 64 + fr, fq * 8), boff = lds_byte(wc * 32 + fr, fq * 8);
#define PG8_SA(b, h) (((b) * 2 + (h)) * HTB)
#define PG8_SB(b, h) ((4 + (b) * 2 + (h)) * HTB)
#define PG8_STAGE(bufoff, gbase, voff) do { _Pragma("unroll") for (int _i = 0; _i < 2; ++_i) \
        __builtin_amdgcn_global_load_lds((const unsigned*)((const char*)(gbase) + (voff)[_i]), (PG8_LAS unsigned*)(lds + (bufoff) + ldsw + _i * 8192), 16, 0, 0); } while (0)
#define PG8_LDA(dst, b, h) do { _Pragma("unroll") for (int m = 0; m < 4; ++m) _Pragma("unroll") for (int k = 0; k < 2; ++k) dst[m][k] = *(const PG8_LAS bf16x8*)(lds + PG8_SA(b, h) + aoff + m * 2048 + k * 1024); } while (0)
#define PG8_LDB(dst, b, h) do { _Pragma("unroll") for (int n = 0; n < 2; ++n) _Pragma("unroll") for (int k = 0; k < 2; ++k) dst[n][k] = *(const PG8_LAS bf16x8*)(lds + PG8_SB(b, h) + boff + n * 2048 + k * 1024); } while (0)
#define PG8_MMA(ai, bj, At, Bt) do { __builtin_amdgcn_s_setprio(1); _Pragma("unroll") for (int m = 0; m < 4; ++m) _Pragma("unroll") for (int n = 0; n < 2; ++n) _Pragma("unroll") for (int k = 0; k < 2; ++k) \
        acc[ai][bj][m][n] = __builtin_amdgcn_mfma_f32_16x16x32_bf16(Bt[n][k], At[m][k], acc[ai][bj][m][n], 0, 0, 0); __builtin_amdgcn_s_setprio(0); } while (0)
#define PG8_WAIT_V(n) asm volatile("s_waitcnt vmcnt(" #n ")" ::: "memory")
#define PG8_WAIT_L(n) asm volatile("s_waitcnt lgkmcnt(" #n ")" ::: "memory")
#define PG8_BAR __builtin_amdgcn_s_barrier()
#define PG8_SCHED __builtin_amdgcn_sched_barrier(0)
    Unit cur, nxt; int ui = 0;
    if (!S.next(0, cur)) return;
    f32x4 acc[2][2][4][2];
#pragma unroll
    for (int a = 0; a < 2; ++a)
#pragma unroll
        for (int b = 0; b < 2; ++b)
#pragma unroll
            for (int m = 0; m < 4; ++m)
#pragma unroll
                for (int n = 0; n < 2; ++n) acc[a][b][m][n] = (f32x4){0.f, 0.f, 0.f, 0.f};
    bf16x8 At[4][2], B0[2][2], B1[2][2];
    const char* cA = (const char*)g.A + (size_t)cur.pm * tstep; const char* cB = (const char*)g.Bt + (size_t)cur.pn * tstep;
    S.a_ready(cur);
    PG8_STAGE(PG8_SB(0, 0), cB, voffB); PG8_STAGE(PG8_SA(0, 0), cA, voffA); PG8_STAGE(PG8_SB(0, 1), cB + hstep, voffB); PG8_STAGE(PG8_SA(0, 1), cA + hstep, voffA);
    if (wr == 1) PG8_BAR;
    PG8_WAIT_V(4); PG8_BAR;
    PG8_STAGE(PG8_SB(1, 0), cB + kstep, voffB); PG8_STAGE(PG8_SA(1, 0), cA + kstep, voffA); PG8_STAGE(PG8_SB(1, 1), cB + hstep + kstep, voffB);
    PG8_WAIT_V(6); PG8_BAR;
    for (;;) {
        const bool has_next = S.next(ui + 1, nxt);
        const char* nA = has_next ? (const char*)g.A + (size_t)nxt.pm * tstep : cA; const char* nB = has_next ? (const char*)g.Bt + (size_t)nxt.pn * tstep : cB;
        for (int t = 0; t < nt; t += 2) {
            const bool last = (t == nt - 2);
            const char* a1 = cA + (size_t)(t + 1) * kstep;
            const char* a2 = last ? nA : cA + (size_t)(t + 2) * kstep; const char* b2 = last ? nB : cB + (size_t)(t + 2) * kstep;
            const char* a3 = a2 + kstep; const char* b3 = b2 + kstep;
            if (last && has_next) S.a_ready(nxt);
            PG8_LDB(B0, 0, 0); PG8_SCHED; PG8_LDA(At, 0, 0); PG8_STAGE(PG8_SA(1, 1), a1 + hstep, voffA);
            PG8_WAIT_L(8); PG8_BAR; PG8_WAIT_L(0); PG8_MMA(0, 0, At, B0); PG8_BAR; PG8_SCHED;
            PG8_LDB(B1, 0, 1); PG8_STAGE(PG8_SB(0, 0), b2, voffB);
            PG8_BAR; PG8_WAIT_L(0); PG8_MMA(0, 1, At, B1); PG8_BAR;
            PG8_LDA(At, 0, 1); PG8_STAGE(PG8_SA(0, 0), a2, voffA);
            PG8_BAR; PG8_WAIT_L(0); PG8_MMA(1, 0, At, B0); PG8_BAR; PG8_SCHED;
            PG8_STAGE(PG8_SB(0, 1), b2 + hstep, voffB);
            PG8_WAIT_V(6); PG8_BAR; PG8_MMA(1, 1, At, B1); PG8_BAR;
            PG8_LDB(B0, 1, 0); PG8_SCHED; PG8_LDA(At, 1, 0); PG8_STAGE(PG8_SA(0, 1), a2 + hstep, voffA);
            PG8_WAIT_L(8); PG8_BAR; PG8_WAIT_L(0); PG8_MMA(0, 0, At, B0); PG8_BAR; PG8_SCHED;
            PG8_LDB(B1, 1, 1); PG8_STAGE(PG8_SB(1, 0), b3, voffB);
            PG8_BAR; PG8_WAIT_L(0); PG8_MMA(0, 1, At, B1); PG8_BAR;
            PG8_LDA(At, 1, 1); PG8_STAGE(PG8_SA(1, 0), a3, voffA);
            PG8_BAR; PG8_WAIT_L(0); PG8_MMA(1, 0, At, B0); PG8_BAR; PG8_SCHED;
            PG8_STAGE(PG8_SB(1, 1), b3 + hstep, voffB);
            PG8_WAIT_V(6); PG8_BAR; PG8_MMA(1, 1, At, B1); PG8_BAR;
        }
        if constexpr (!Epi::AFTER_DRAIN) { E(acc, cur, wr, wc, fr, fq); S.done(cur); }
        if (!has_next) break;
#pragma unroll
        for (int a = 0; a < 2; ++a)
#pragma unroll
            for (int b = 0; b < 2; ++b)
#pragma unroll
                for (int m = 0; m < 4; ++m)
#pragma unroll
                    for (int n = 0; n < 2; ++n) acc[a][b][m][n] = (f32x4){0.f, 0.f, 0.f, 0.f};
        cur = nxt; cA = nA; cB = nB; ++ui;
    }
    PG8_WAIT_V(0);
    if (wr == 0) PG8_BAR;
    PG8_BAR;
    if constexpr (Epi::AFTER_DRAIN) { E.fused(acc, cur, wr, wc, fr, fq, lds, wid, lane); S.done(cur); }
#undef PG8_SA
#undef PG8_SB
#undef PG8_STAGE
#undef PG8_LDA
#undef PG8_LDB
#undef PG8_MMA
#undef PG8_WAIT_V
#undef PG8_WAIT_L
#undef PG8_BAR
#undef PG8_SCHED
}

}
template <class PEpi>
DEVFN void ph_gemm8(const bf16_t* A, const bf16_t* Wt, int K, int N, const PEpi& E, char* smem) {
  pg8::StaticOrder S; S.init(T, N, (int)gridDim.x, (int)blockIdx.x);
  pg8::gemm_phase<PEpi, pg8::StaticOrder>((PG8_LAS unsigned char*)smem, pg8::Gemm{A, Wt, T, N, K}, S, E);
}
#define GEMM_SCALE(A, Wt, K, N, rinvp, outp) ph_gemm8(A, Wt, K, N, pg8::PEpiScaleBf16{rinvp, outp, N}, smem)
#define GEMM_GLU(A, Wt, K, N, yprep, biasp, outp) ph_gemm8(A, Wt, K, N, pg8::PEpiGlu{yprep, biasp, outp}, smem)
#define GEMM_RES(A, Wt, K, N, hinp, houtp, hbp) ph_gemm8(A, Wt, K, N, pg8::PEpiResidual{hinp, houtp, hbp}, smem)
#else
#define GEMM_SCALE(A, Wt, K, N, rinvp, outp) ph_gemm(A, K, Wt, K, N, EpiScaleBf16{rinvp, outp, N}, smem)
#define GEMM_GLU(A, Wt, K, N, yprep, biasp, outp) ph_gemm(A, K, Wt, K, N, EpiGlu{yprep, biasp, outp}, smem)
#define GEMM_RES(A, Wt, K, N, hinp, houtp, hbp) ph_gemm(A, K, Wt, K, N, EpiResidual{hinp, houtp, hbp}, smem)
#endif

DEVFN void s5_bu(const bf16_t* __restrict__ pb, const S5Tab& tb, int tok0, int g, int lane, int pp, f32x16 (&acc)[2][2]) {
  const int half = lane >> 5, i = lane & 31;
  const int tau = 16 * ((i >> 2) & 1) + 4 * (i >> 3) + (i & 3);
  bf16x8 au[2], bb[2];
#pragma unroll
  for (int mt = 0; mt < 2; ++mt) au[mt] = *(const bf16x8*)(pb + (size_t)(tok0 + mt * 32 + tau) * EVEN_IN + g * 16 + 8 * half);
#pragma unroll
  for (int part = 0; part < 2; ++part) bb[part] = *(const bf16x8*)(tb.bbT + ((size_t)g * 128 + (2 * part + pp) * 32 + i) * 16 + 8 * half);
#pragma unroll
  for (int mt = 0; mt < 2; ++mt)
#pragma unroll
    for (int part = 0; part < 2; ++part) {
#pragma unroll
      for (int r = 0; r < 16; ++r) acc[mt][part][r] = 0.f;
      acc[mt][part] = mfma32(au[mt], bb[part], acc[mt][part]);
    }
}
DEVFN void s5_local_scan(f32x16 (&acc)[2][2], float ar, float ai) {
#pragma unroll
  for (int mt = 0; mt < 2; ++mt)
#pragma unroll
    for (int k = 1; k < 16; ++k) {
      const float pr = acc[mt][0][k - 1], pi = acc[mt][1][k - 1];
      acc[mt][0][k] += ar * pr - ai * pi;
      acc[mt][1][k] += ar * pi + ai * pr;
    }
}
DEVFN void s5_carries(const f32x16 (&acc)[2][2], int half, float a16r, float a16i, float c0r, float c0i, float (&csr)[5], float (&csi)[5]) {
  float er[4], ei[4];
#pragma unroll
  for (int mt = 0; mt < 2; ++mt) {
    const float ownr = acc[mt][0][15], owni = acc[mt][1][15];
    const float parr = partner32(ownr), pari = partner32(owni);
    er[2 * mt] = half ? parr : ownr; ei[2 * mt] = half ? pari : owni;
    er[2 * mt + 1] = half ? ownr : parr; ei[2 * mt + 1] = half ? owni : pari;
  }
  csr[0] = c0r; csi[0] = c0i;
#pragma unroll
  for (int j = 0; j < 4; ++j) { csr[j + 1] = a16r * csr[j] - a16i * csi[j] + er[j]; csi[j + 1] = a16r * csi[j] + a16i * csr[j] + ei[j]; }
}
DEVFN void ph_s5_pass1(const Params& P) {
  const int tid = TIDX, lane = tid & 63, wv = tid >> 6, half = lane >> 5;
  const S5Tab& tb = P.tb;
  for (int item = blockIdx.x * NWV + wv; item < NB * NCH * NG; item += gridDim.x * NWV) {
    const int g = item % NG, ch = (item / NG) % NCH, b = item / (NG * NCH);
    float* dst = P.S + ((size_t)(b * NCH + ch) * NG + g) * 128;
#pragma unroll
    for (int pp = 0; pp < 2; ++pp) {
      const int p = pp * 32 + (lane & 31);
      f32x16 acc[2][2];
      s5_bu(P.pb, tb, b * SEQ + ch * SQ, g, lane, pp, acc);
      s5_local_scan(acc, tb.ar[g * NST + p], tb.ai[g * NST + p]);
      float csr[5], csi[5];
      s5_carries(acc, half, tb.a16r[g * NST + p], tb.a16i[g * NST + p], 0.f, 0.f, csr, csi);
      if (half == 0) { dst[p] = csr[4]; dst[64 + p] = csi[4]; }
    }
  }
}
DEVFN void ph_s5_pass2(const Params& P) {
  for (int gid = blockIdx.x * NT + TIDX; gid < NB * NG * NST; gid += gridDim.x * NT) {
  const int p = gid % NST, g = (gid / NST) % NG, b = gid / (NST * NG), gp = g * NST + p;
  const float qr = P.tb.aqr[gp], qi = P.tb.aqi[gp];
  const float* __restrict__ S = P.S; float* __restrict__ S2 = P.S2;
  float hr = 0.f, hi = 0.f;
  for (int c0 = 0; c0 < NCH; c0 += 8) {
    float sr[8], si[8];
#pragma unroll
    for (int j = 0; j < 8; ++j) { const float* d = S + ((size_t)(b * NCH + c0 + j) * NG + g) * 128; sr[j] = d[p]; si[j] = d[64 + p]; }
#pragma unroll
    for (int j = 0; j < 8; ++j) {
      float* d = S2 + ((size_t)(b * NCH + c0 + j) * NG + g) * 128;
      d[p] = hr; d[64 + p] = hi;
      float nr = qr * hr - qi * hi + sr[j], ni = qr * hi + qi * hr + si[j];
      hr = nr; hi = ni;
    }
  }
  }
}
constexpr int HLD = 128 + 8;
DEVFN void ph_s5_pass3(const Params& P, char* smem) {
  const int tid = TIDX, lane = tid & 63, wv = tid >> 6, half = lane >> 5, l31 = lane & 31;
  bf16_t* Hl = (bf16_t*)(smem + wv * (64 * HLD * 2));
  const S5Tab& tb = P.tb;
  for (int item = blockIdx.x * NWV + wv; item < NB * NCH * NG; item += gridDim.x * NWV) {
    const int g = item % NG, ch = (item / NG) % NCH, b = item / (NG * NCH);
    const int tok0 = b * SEQ + ch * SQ;
    const float* src = P.S2 + ((size_t)(b * NCH + ch) * NG + g) * 128;
    WAVE_SYNC();
#pragma unroll
    for (int pp = 0; pp < 2; ++pp) {
      const int p = pp * 32 + l31;
      const float ar = tb.ar[g * NST + p], ai = tb.ai[g * NST + p];
      f32x16 acc[2][2];
      s5_bu(P.pb, tb, tok0, g, lane, pp, acc);
      s5_local_scan(acc, ar, ai);
      float csr[5], csi[5];
      s5_carries(acc, half, tb.a16r[g * NST + p], tb.a16i[g * NST + p], src[p], src[64 + p], csr, csi);
#pragma unroll
      for (int mt = 0; mt < 2; ++mt) {
        const float cr = half ? csr[2 * mt + 1] : csr[2 * mt], ci = half ? csi[2 * mt + 1] : csi[2 * mt];
        float pr = ar, pi = ai;
#pragma unroll
        for (int k = 0; k < 16; ++k) {
          const float hr = acc[mt][0][k] + pr * cr - pi * ci, hi = acc[mt][1][k] + pr * ci + pi * cr;
          const float nr = pr * ar - pi * ai, ni = pr * ai + pi * ar;
          pr = nr; pi = ni;
          *(unsigned*)(Hl + (mt * 32 + 16 * half + k) * HLD + 4 * l31 + 2 * pp) = pack2(hr, hi);
        }
      }
    }
    WAVE_SYNC();
    f32x16 y[2];
#pragma unroll
    for (int mt = 0; mt < 2; ++mt)
#pragma unroll
      for (int r = 0; r < 16; ++r) y[mt][r] = 0.f;
    const bf16x8 zero8 = {0, 0, 0, 0, 0, 0, 0, 0};
#pragma unroll
    for (int ks = 0; ks < 9; ++ks) {
      const bf16x8 fb = l31 < 16 ? *(const bf16x8*)(tb.cmP + ((size_t)g * 16 + l31) * CMK + ks * 16 + 8 * half) : zero8;
#pragma unroll
      for (int mt = 0; mt < 2; ++mt) {
        const bf16x8 fa = ks < 8 ? *(const bf16x8*)(Hl + (mt * 32 + l31) * HLD + ks * 16 + 8 * half)
                                 : *(const bf16x8*)(P.pb + (size_t)(tok0 + mt * 32 + l31) * EVEN_IN + g * 16 + 8 * half);
        y[mt] = mfma32(fa, fb, y[mt]);
      }
    }
    if (l31 < 16) {
#pragma unroll
      for (int mt = 0; mt < 2; ++mt)
#pragma unroll
        for (int r = 0; r < 16; ++r) {
          const int t = mt * 32 + (r & 3) + 8 * (r >> 2) + 4 * half;
          P.ya[(size_t)(tok0 + t) * AW + g * 16 + l31] = f2bf(gelu_f(y[mt][r]));
        }
    }
  }
}

DEVFN void ph_conv(const Params& P) {
  const bf16_t* __restrict__ pb = P.pb; const float* __restrict__ cw = P.in[13]; bf16_t* __restrict__ cb = P.cb;
  const int per_row = AW / 8;
  for (int e = blockIdx.x * NT + TIDX; e < T * per_row; e += gridDim.x * NT) {
    const int t = e / per_row, c0 = (e % per_row) * 8;
    const int l = t % SEQ;
    const bf16_t* row = pb + (size_t)t * EVEN_IN;
    float acc[8];
#pragma unroll
    for (int j = 0; j < 8; ++j) acc[j] = 0.f;
#pragma unroll
    for (int d = 0; d < 3; ++d) {
      if (l - 2 + d < 0) continue;
      const bf16_t* r2 = row - (size_t)(2 - d) * EVEN_IN;
      u32x4 cg = *(const u32x4*)(r2 + 2 * AW + c0), xi = *(const u32x4*)(r2 + 3 * AW + c0);
      const unsigned cgs[4] = {cg.x, cg.y, cg.z, cg.w}, xis[4] = {xi.x, xi.y, xi.z, xi.w};
#pragma unroll
      for (int j = 0; j < 4; ++j) {
        acc[2 * j] += cw[d * AW + c0 + 2 * j] * bflo(cgs[j]) * bflo(xis[j]);
        acc[2 * j + 1] += cw[d * AW + c0 + 2 * j + 1] * bfhi(cgs[j]) * bfhi(xis[j]);
      }
    }
    u32x4 bg = *(const u32x4*)(row + AW + c0);
    const unsigned bgs[4] = {bg.x, bg.y, bg.z, bg.w};
    unsigned w[4];
#pragma unroll
    for (int j = 0; j < 4; ++j) w[j] = pack2(bflo(bgs[j]) * acc[2 * j], bfhi(bgs[j]) * acc[2 * j + 1]);
    *(u32x4*)(cb + (size_t)t * DM + AW + c0) = u32x4{w[0], w[1], w[2], w[3]};
  }
}

DEVFN int f2key(float f) { const int b = __builtin_bit_cast(int, f); return b ^ ((b >> 31) & 0x7fffffff); }
DEVFN float key2f(int k) { return __builtin_bit_cast(float, k ^ ((k >> 31) & 0x7fffffff)); }
DEVFN int imax(int a, int b) { return a > b ? a : b; }
DEVFN int imin(int a, int b) { return a < b ? a : b; }
DEVFN void cmpx(int& a, int& b) { const int hi = imax(a, b), lo = imin(a, b); a = hi; b = lo; }
DEVFN void merge_partner(int (&v)[16]) {
  int pv[16];
#pragma unroll
  for (int k = 0; k < 16; ++k) pv[k] = __shfl_xor(v[k], 32);
#pragma unroll
  for (int k = 0; k < 16; ++k) v[k] = imax(v[k], pv[15 - k]);
#pragma unroll
  for (int st = 8; st >= 1; st >>= 1)
#pragma unroll
    for (int k = 0; k < 16; ++k)
      if ((k & st) == 0) cmpx(v[k], v[k + st]);
}
DEVFN void sort16_desc(int (&v)[16]) {
#pragma unroll
  for (int k = 2; k <= 16; k <<= 1)
#pragma unroll
    for (int j = k >> 1; j >= 1; j >>= 1)
#pragma unroll
      for (int i = 0; i < 16; ++i) {
        const int l = i ^ j;
        if (l > i) { if ((i & k) == 0) cmpx(v[i], v[l]); else cmpx(v[l], v[i]); }
      }
}
DEVFN void merge16_desc(int (&a)[16], const int (&b)[16]) {
#pragma unroll
  for (int k = 0; k < 16; ++k) a[k] = imax(a[k], b[15 - k]);
#pragma unroll
  for (int st = 8; st >= 1; st >>= 1)
#pragma unroll
    for (int k = 0; k < 16; ++k)
      if ((k & st) == 0) cmpx(a[k], a[k + st]);
}
constexpr int KLD = 128 + 8;
DEVFN void topk_part(const bf16_t* __restrict__ qp, const bf16_t* sk, int lane, int half, int (&kv)[16]) {
  f32x16 acc[4];
#pragma unroll
  for (int mi = 0; mi < 4; ++mi)
#pragma unroll
    for (int r = 0; r < 16; ++r) acc[mi][r] = 0.f;
#pragma unroll
  for (int s = 0; s < 8; ++s) {
    const bf16x8 fb = *(const bf16x8*)(qp + s * 16);
#pragma unroll
    for (int mi = 0; mi < 4; ++mi) {
      const bf16x8 fa = *(const bf16x8*)(sk + (mi * 32 + (lane & 31)) * KLD + s * 16 + 8 * half);
      acc[mi] = mfma32(fa, fb, acc[mi]);
    }
  }
  const int hb = 4 * half;
  int g[4][16];
#pragma unroll
  for (int mi = 0; mi < 4; ++mi) {
#pragma unroll
    for (int r = 0; r < 16; ++r) g[mi][r] = (f2key(acc[mi][r]) & ~127) | (127 - (mi * 32 + (r & 3) + 8 * (r >> 2)) - hb);
    sort16_desc(g[mi]);
  }
  merge16_desc(g[0], g[1]); merge16_desc(g[2], g[3]); merge16_desc(g[0], g[2]);
#pragma unroll
  for (int k = 0; k < 16; ++k) kv[k] = g[0][k];
  merge_partner(kv);
}
constexpr int pair_ab(int idx) { int n = 0; for (int a = 0; a < 16; ++a) for (int b = 0; b < 16; ++b) if ((a + 1) * (b + 1) <= 16) { if (n == idx) return a * 16 + b; ++n; } return 0; }
template <int I> DEVFN void cand_step(const float (&v1f)[16], const float (&v2f)[16], int half, int (&ck)[16]) {
  constexpr int p0 = pair_ab(2 * I), p1 = pair_ab(2 * I + 1);
  const float s0 = v1f[p0 >> 4] + v2f[p0 & 15], s1 = v1f[p1 >> 4] + v2f[p1 & 15];
  int x = (f2key(half ? s1 : s0) & ~255) | (half ? (255 - p1) : (255 - p0));
#pragma unroll
  for (int k = 0; k < 16; ++k) if (k < I) cmpx(ck[k], x);
  if (I < 16) ck[I < 16 ? I : 0] = x;
}
template <int... I> DEVFN void cand_all(const float (&v1f)[16], const float (&v2f)[16], int half, int (&ck)[16], std::integer_sequence<int, I...>) { (cand_step<I>(v1f, v2f, half, ck), ...); }
DEVFN void ph_topk(const bf16_t* __restrict__ q, const bf16_t* __restrict__ k1, const bf16_t* __restrict__ k2,
                   int* __restrict__ idx_out, float* __restrict__ gate_out, char* smem) {
  bf16_t* sk = (bf16_t*)smem;
  const int tid = TIDX, lane = tid & 63, wv = tid >> 6, half = lane >> 5;
  unsigned char* lut = (unsigned char*)(smem + 2 * 128 * KLD * 2) + (wv * 64 + lane) * 32;
  constexpr int NITEM = (T / 256) * PH;
  const int iters = (NITEM + gridDim.x - 1) / gridDim.x;
  int h_lds = -1;
  for (int it = 0; it < iters; ++it) {
    const int item = it * gridDim.x + blockIdx.x;
    const bool act = item < NITEM;
    const int h = item % PH, tile = item / PH;
    if (h != h_lds) {
      __syncthreads();
      if (act)
        for (int e = tid; e < 2 * 128 * 16; e += NT) {
          const int part = e >> 11, row = (e >> 4) & 127, c8 = (e & 15) * 8;
          *(u32x4*)(sk + (part * 128 + row) * KLD + c8) = *(const u32x4*)((part ? k2 : k1) + ((size_t)h * NKEY + row) * 128 + c8);
        }
      __syncthreads();
      h_lds = act ? h : -1;
    }
    if (!act) continue;
    const int tok = tile * 256 + wv * 32 + (lane & 31);
    int kv1[16], kv2[16];
    topk_part(q + (size_t)tok * QN + h * 256 + 8 * half, sk, lane, half, kv1);
    topk_part(q + (size_t)tok * QN + h * 256 + 128 + 8 * half, sk + 128 * KLD, lane, half, kv2);
    float v1f[16], v2f[16];
#pragma unroll
    for (int k = 0; k < 16; ++k) {
      v1f[k] = key2f(kv1[k] & ~127); v2f[k] = key2f(kv2[k] & ~127);
      lut[k] = (unsigned char)(127 - (kv1[k] & 127)); lut[16 + k] = (unsigned char)(127 - (kv2[k] & 127));
    }
    int ck[16];
    cand_all(v1f, v2f, half, ck, std::make_integer_sequence<int, 25>{});
    merge_partner(ck);
    unsigned oi[8]; float og[8];
#pragma unroll
    for (int j = 0; j < 8; ++j) {
      int k0 = ck[j], k1 = ck[8 + j];
      OPAQUE(k0); OPAQUE(k1);
      const int kk = half ? k1 : k0;
      const int pos = 255 - (kk & 255);
      oi[j] = (unsigned)lut[pos >> 4] * NKEY + (unsigned)lut[16 + (pos & 15)];
      og[j] = key2f(kk & ~255);
    }
    const size_t o = (size_t)tok * NSEL + h * TOPK + 8 * half;
    *(u32x4*)(idx_out + o) = u32x4{oi[0], oi[1], oi[2], oi[3]}; *(u32x4*)(idx_out + o + 4) = u32x4{oi[4], oi[5], oi[6], oi[7]};
    *(f32x4*)(gate_out + o) = f32x4{og[0], og[1], og[2], og[3]}; *(f32x4*)(gate_out + o + 4) = f32x4{og[4], og[5], og[6], og[7]};
  }
}

#ifdef HOST_EMU
struct XcdBarrier { int dummy; };
#endif
#ifndef HOST_EMU
#define XB_TMO      128
#define XB_XCNT(j)  (256  + 64 * (j))
#define XB_XSUB(j)  (1280 + 64 * (j))
#define XB_XGEN(j)  (2304 + 64 * (j))
#define XB_TOP      3328
#define XB_TOPGEN   3392
#define XB_PACE(j)  (3456 + 64 * (j))
#define XCD_BAR_WORDS 4480
#define XB_SPIN_CAP (1u << 20)
#define LAS __attribute__((address_space(3)))
DEVFN unsigned xb_ld(unsigned* p)              { return __hip_atomic_load(p, __ATOMIC_RELAXED, __HIP_MEMORY_SCOPE_AGENT); }
DEVFN unsigned xb_add(unsigned* p, unsigned v) { return __hip_atomic_fetch_add(p, v, __ATOMIC_RELAXED, __HIP_MEMORY_SCOPE_AGENT); }
DEVFN unsigned xb_xcc_id() { return (unsigned)__builtin_amdgcn_s_getreg((3 << 11) | 20) & 0xFu; }
#define XB_SPIN(cond, bar) do { unsigned _sp = 0; while (cond) { __builtin_amdgcn_s_sleep(1); \
    if ((++_sp & 255u) == 0u) { if (xb_ld(&(bar)[XB_TMO])) break; if (_sp > XB_SPIN_CAP) { atomicAdd(&(bar)[XB_TMO], 1u); break; } } } } while (0)
struct XcdBarrier { unsigned* bar; unsigned x; volatile LAS unsigned* st; };
DEVFN XcdBarrier xcd_barrier_post(unsigned* bar, volatile LAS unsigned* st) {
  XcdBarrier b; b.bar = bar; b.x = xb_xcc_id(); b.st = st;
  if (threadIdx.x == 0) (void)xb_add(&bar[XB_XCNT(b.x)], 1u);
  return b;
}
DEVFN void xcd_barrier_complete(unsigned* bar, unsigned x, unsigned& nloc, unsigned& nx) {
  const unsigned G = gridDim.x * gridDim.y * gridDim.z;
  unsigned sum, cnt, mine, sp = 0u;
  for (;;) {
    sum = 0u; cnt = 0u; mine = 0u;
#pragma unroll
    for (unsigned j = 0; j < 16; ++j) { const unsigned c = xb_ld(&bar[XB_XCNT(j)]); sum += c; cnt += (c > 0u) ? 1u : 0u; mine = (j == x) ? c : mine; }
    if (sum == G) break;
    __builtin_amdgcn_s_sleep(1);
    if ((++sp & 255u) == 0u) { if (xb_ld(&bar[XB_TMO])) break; if (sp > XB_SPIN_CAP) { atomicAdd(&bar[XB_TMO], 1u); break; } }
  }
  nloc = mine > 0u ? mine : 1u; nx = cnt > 0u ? cnt : 1u;
}
DEVFN void xcd_barrier(const XcdBarrier& b) {
  asm volatile("s_waitcnt vmcnt(0)" ::: "memory");
  __syncthreads();
  if (threadIdx.x == 0) {
    unsigned* bar = b.bar;
    __builtin_amdgcn_s_waitcnt(0);
    unsigned nloc = b.st[0], nx = b.st[1];
    if (nloc == 0u) { xcd_barrier_complete(bar, b.x, nloc, nx); b.st[0] = nloc; b.st[1] = nx; }
    const unsigned old = xb_add(&bar[XB_XSUB(b.x)], 1u);
    const unsigned gen = old / nloc;
    if (old + 1u == (gen + 1u) * nloc) {
      __builtin_amdgcn_fence(__ATOMIC_RELEASE, "agent");
      asm volatile("s_waitcnt vmcnt(0)" ::: "memory");
      const unsigned og = xb_add(&bar[XB_TOP], 1u);
      const unsigned tg = og / nx;
      if (og + 1u == (tg + 1u) * nx) xb_add(&bar[XB_TOPGEN], 1u);
      else XB_SPIN(xb_ld(&bar[XB_TOPGEN]) == tg, bar);
      __builtin_amdgcn_fence(__ATOMIC_ACQUIRE, "agent");
      xb_add(&bar[XB_XGEN(b.x)], 1u);
      asm volatile("s_waitcnt vmcnt(0)" ::: "memory");
    } else {
      XB_SPIN(xb_ld(&bar[XB_XGEN(b.x)]) == gen, bar);
      __builtin_amdgcn_fence(__ATOMIC_ACQUIRE, "agent");
      asm volatile("s_waitcnt vmcnt(0)" ::: "memory");
    }
  }
  __syncthreads();
}
#define XSYNC() xcd_barrier(xb)
constexpr unsigned PACE_LAG = 1;
struct XcdPace { unsigned* ctr; unsigned nloc; unsigned step; };
DEVFN unsigned sload_glc(const unsigned* p) {
  unsigned v;
  const unsigned long long a = (unsigned long long)p;
  p = (const unsigned*)(((unsigned long long)(unsigned)__builtin_amdgcn_readfirstlane((int)(a >> 32)) << 32) | (unsigned)__builtin_amdgcn_readfirstlane((int)a));
  asm volatile("s_load_dword %0, %1, 0x0 glc\n\ts_waitcnt lgkmcnt(0)" : "=s"(v) : "s"(p) : "memory");
  return v;
}
DEVFN XcdPace xcd_pace_init(const XcdBarrier& b, int which) {
  XcdPace pc; pc.ctr = b.bar + XB_PACE(b.x) + 32 * which; pc.nloc = (unsigned)__builtin_amdgcn_readfirstlane((int)b.st[0]); pc.step = 0u;
  return pc;
}
#ifndef CFG_XPACE
#define CFG_XPACE 0
#endif
DEVFN void xcd_pace(XcdPace& pc) {
  ++pc.step;
  if (CFG_XPACE && __builtin_amdgcn_readfirstlane((int)(threadIdx.x >> 6)) == 0) {
    if (threadIdx.x == 0) (void)xb_add(pc.ctr, 1u);
    if (pc.step > PACE_LAG) {
      const unsigned need = pc.nloc * (pc.step - PACE_LAG);
      if ((int)(sload_glc(pc.ctr) - need) < 0) {
        unsigned sp = 0u;
        while ((int)(xb_ld(pc.ctr) - need) < 0) { __builtin_amdgcn_s_sleep(1); if (++sp > (1u << 16)) break; }
      }
    }
  }
  __syncthreads();
}
#else
#define XCD_BAR_WORDS 3456
#define XSYNC() emu_grid_sync()
struct XcdPace { int step; };
DEVFN XcdPace xcd_pace_init(const XcdBarrier&, int) { return XcdPace{0}; }
DEVFN void xcd_pace(XcdPace& pc) { ++pc.step; __syncthreads(); }
#endif


static_assert(EW == 4 || EW == 2, "row vector width");
constexpr int IDXR = (NSEL + 63) / 64;
#ifndef CFG_GPACE
#define CFG_GPACE 0
#endif
#ifndef CFG_GSH
#define CFG_GSH 11
#endif
#ifndef CFG_UPM
#define CFG_UPM 12
#endif
#ifndef CFG_VPM
#define CFG_VPM 4
#endif
constexpr int GSH = CFG_GSH;
constexpr int UPM = CFG_UPM;
constexpr int VPM = CFG_VPM;
constexpr int RB = 8;
struct RowBatch { unsigned w[RB][EW]; };
DEVFN void load_row(const unsigned char* __restrict__ p, int lane, unsigned (&w)[EW]) {
  if constexpr (EW == 4) { u32x4 x = *(const u32x4*)(p + lane * EPL); w[0] = x.x; w[1] = x.y; w[2] = x.z; w[3] = x.w; }
  else { u32x2 x = *(const u32x2*)(p + lane * EPL); w[0] = x.x; w[1] = x.y; }
}
constexpr int NTW = 4;
constexpr int NENT = NTW * NSEL;
constexpr int ENTR = NENT / 64;
static_assert(RB == 2 * NTW && NENT % 64 == 0 && NSEL % 16 == 0 && NSEL % 4 == 0 && (T % NTW) == 0, "gather group shape");
DEVFN int bucket_of(int e) {
  constexpr int NB = NEXP >> GSH;
  const int i = e / NKEY, j = e % NKEY;
  return ((i * NB) / NKEY + (j * NB) / NKEY) % NB;
}
DEVFN int uni_i(int v) {
#ifndef HOST_EMU
  return __builtin_amdgcn_readfirstlane(v);
#else
  return v;
#endif
}
DEVFN float uni_f(float v) { return __builtin_bit_cast(float, uni_i(__builtin_bit_cast(int, v))); }
DEVFN float dot_row(const unsigned (&w)[EW], const f32x2 (&hx)[2 * EW]) {
  f32x2 a = {0.f, 0.f};
#pragma unroll
  for (int k = 0; k < EW; ++k) { a += unpack_fp8_lo(w[k]) * hx[2 * k]; a += unpack_fp8_hi(w[k]) * hx[2 * k + 1]; }
  return a.x + a.y;
}
DEVFN void pk_fma_acc(f32x2& acc, f32x2 val, float c) {
#ifndef HOST_EMU
  const unsigned long long cs = (unsigned long long)__builtin_bit_cast(unsigned, c);
  asm("v_pk_fma_f32 %0, %1, %2, %0 op_sel_hi:[1,0,1]" : "+v"(acc) : "v"(val), "s"(cs));
#else
  acc += val * c;
#endif
}
DEVFN void axpy_row(const unsigned (&w)[EW], float c, f32x2 (&acc)[2 * EW]) {
#pragma unroll
  for (int g = 0; g < U4W; ++g) {
    pk_fma_acc(acc[4 * g], unpack_fp4<0>(w[U4W + g]), c); pk_fma_acc(acc[4 * g + 1], unpack_fp4<1>(w[U4W + g]), c);
    pk_fma_acc(acc[4 * g + 2], unpack_fp4<2>(w[U4W + g]), c); pk_fma_acc(acc[4 * g + 3], unpack_fp4<3>(w[U4W + g]), c);
  }
}
template <bool ISU>
DEVFN void gather4_load(RowBatch& B, int s0, const int* srt, int lane, int jr, const unsigned char* __restrict__ tab, const float* __restrict__ su, const float* __restrict__ sv) {
#pragma unroll
  for (int j = 0; j < RB; ++j) {
    const int e = uni_i(srt[(j % NTW) * NSEL + s0 + j / NTW]);
    load_row(tab + (size_t)e * DM, lane, B.w[j]);
  }
}
DEVFN float gather4_u(const RowBatch& B, int s0, const int (&hq)[NTW][EW], float shl, const float* sgt, const float* sut, int lane, int jr) {
  float d[RB];
#pragma unroll
  for (int j = 0; j < RB; ++j) {
    int ah = 0, al = 0;
#pragma unroll
    for (int g = 0; g < U4W; ++g) { ah = sdot8((int)B.w[j][g], hq[j % NTW][g], ah); al = sdot8((int)B.w[j][g], hq[j % NTW][U4W + g], al); }
    d[j] = (float)(16 * ah + al);
  }
  float r4[4], r2[2];
#pragma unroll
  for (int i = 0; i < 4; ++i) { swap32(d[i], d[i + 4]); r4[i] = d[i] + d[i + 4]; }
#pragma unroll
  for (int i = 0; i < 2; ++i) { swap16(r4[i], r4[i + 2]); r2[i] = r4[i] + r4[i + 2]; }
  const float t0 = r2[0] + dpp_f<0x128>(r2[0]), t1 = r2[1] + dpp_f<0x128>(r2[1]);
  float r = (lane & 8) ? t1 : t0;
  r += dpp_f<0x141>(r); r += dpp_f<0xB1>(r); r += dpp_f<0x4E>(r);
  const int li = (jr % NTW) * NSEL + s0 + jr / NTW;
  return sgt[li] * gelu_f(sut[li] * shl * r);
}
DEVFN void gather4_v(const RowBatch& B, float cf, f32x2 (&acc)[NTW][2 * EW]) {
#pragma unroll
  for (int j = 0; j < RB; ++j) axpy_row(B.w[j], bcast_lane(cf, 32 * ((j >> 2) & 1) + 16 * ((j >> 1) & 1) + 8 * (j & 1)), acc[j % NTW]);
}
DEVFN void ph_gather4(float* hio, const float* __restrict__ gn, const int* __restrict__ idx, const float* __restrict__ gate,
                      const unsigned char* __restrict__ ut, const unsigned char* __restrict__ vt, const float* __restrict__ su, const float* __restrict__ sv,
                      bf16_t* __restrict__ hb, float* __restrict__ rinv_next, const float* __restrict__ gfinal, char* smem, const XcdBarrier& xb, int which) {
  const int lane = TIDX & 63;
  XcdPace pc = xcd_pace_init(xb, which);
  static_assert(UPM == 12 && NSEL / 2 >= 16, "stagger assumes a pacing interval of 16 batches");
  const int pstag = uni_i(TIDX >> 6) >= NWV / 2 ? 8 : 0;
  int* srt = (int*)(smem + uni_i(TIDX >> 6) * (4 * NENT * 4));
  float* sgt = (float*)(srt + NENT);
  float* coefl = (float*)(srt + 2 * NENT);
  float* sut = (float*)(srt + 3 * NENT);
  const int jr = ((lane >> 5) & 1) * 4 + ((lane >> 4) & 1) * 2 + ((lane >> 3) & 1);
  constexpr int NGRP = T / NTW;
  const int g_iters = (NGRP + gridDim.x * NWV - 1) / (gridDim.x * NWV);
  for (int g_it = 0; g_it < g_iters; ++g_it) {
    const int g_raw = (g_it * gridDim.x + blockIdx.x) * NWV + uni_i(TIDX >> 6);
    const bool g_act = g_raw < NGRP;
    const int t0 = (g_act ? g_raw : NGRP - 1) * NTW;
    int hq[NTW][EW];
    float ri[NTW], sh[NTW];
#pragma unroll
    for (int k = 0; k < NTW; ++k) {
      f32x4 hv[EW];
      float ss = 0.f;
#pragma unroll
      for (int q = 0; q < EW; ++q) { hv[q] = *(const f32x4*)(hio + (size_t)(t0 + k) * DM + lane * EPL + 4 * q); ss += hv[q].x * hv[q].x + hv[q].y * hv[q].y + hv[q].z * hv[q].z + hv[q].w * hv[q].w; }
      ss = wave_sum(ss);
      ri[k] = rsqrtf(ss * (1.0f / DM) + RMS_EPS);
      float mxh = 0.f;
#pragma unroll
      for (int q = 0; q < EW; ++q) {
        const f32x4 gv = *(const f32x4*)(gn + lane * EPL + 4 * q);
        hv[q] = f32x4{hv[q].x * ri[k] * gv.x, hv[q].y * ri[k] * gv.y, hv[q].z * ri[k] * gv.z, hv[q].w * ri[k] * gv.w};
        mxh = fmaxf(mxh, fmaxf(fmaxf(fabsf(hv[q].x), fabsf(hv[q].y)), fmaxf(fabsf(hv[q].z), fabsf(hv[q].w))));
      }
      mxh = row16_max(mxh);
      { float a = mxh, b = mxh; swap16(a, b); mxh = fmaxf(mxh, (threadIdx.x & 16) ? a : b); }
      mxh = fmaxf(fmaxf(mxh, partner32(mxh)), 1e-30f);
      sh[k] = mxh * (1.0f / 119.0f);
      const float qi = 119.0f / mxh;
#pragma unroll
      for (int g = 0; g < U4W; ++g) {
        const float e8[8] = {hv[2 * g].x, hv[2 * g].y, hv[2 * g].z, hv[2 * g].w, hv[2 * g + 1].x, hv[2 * g + 1].y, hv[2 * g + 1].z, hv[2 * g + 1].w};
        unsigned wh = 0u, wl = 0u;
#pragma unroll
        for (int i = 0; i < 8; ++i) {
          const int t = (int)rintf(e8[i] * qi);
          const int tl = ((t + 8) & 15) - 8, th = (t - tl) >> 4;
          wh |= ((unsigned)th & 15u) << (4 * i); wl |= ((unsigned)tl & 15u) << (4 * i);
        }
        hq[k][g] = (int)wh; hq[k][U4W + g] = (int)wl;
      }
    }
    const float shl = (jr % NTW) == 0 ? sh[0] : (jr % NTW) == 1 ? sh[1] : (jr % NTW) == 2 ? sh[2] : sh[3];
    {
      int ent[ENTR]; float gt[ENTR], sue[ENTR]; int pos[ENTR];
#pragma unroll
      for (int r = 0; r < ENTR; ++r) {
        const int e = r * 64 + lane, k = e / NSEL, sl = e % NSEL;
        const float rik = k == 0 ? ri[0] : k == 1 ? ri[1] : k == 2 ? ri[2] : ri[3];
        ent[r] = idx[(size_t)(t0 + k) * NSEL + sl];
        const float raw = gate[(size_t)(t0 + k) * NSEL + sl];
        const float ex = __expf(rik * (raw - row16_max(raw)));
        gt[r] = ex / row16_sum(ex) * sv[ent[r]]; pos[r] = 0;
        sue[r] = su[ent[r]];
      }
#pragma unroll
      for (int k = 0; k < NTW; ++k) {
        constexpr int dummy = 0; (void)dummy;
        const int r_lo = (k * NSEL) / 64, r_hi = ((k + 1) * NSEL + 63) / 64;
        int base = k * NSEL;
        for (int v = 0; v < (NEXP >> GSH); ++v) {
#pragma unroll
          for (int r = 0; r < ENTR; ++r) {
            if (r < r_lo || r >= r_hi) continue;
            const bool mine = ((r * 64 + lane) / NSEL == k) && (bucket_of(ent[r]) == v);
            const unsigned long long m = wave_ballot(mine);
            pos[r] = mine ? base + mbcnt64(m, lane) : pos[r];
            base += __builtin_popcountll(m);
          }
        }
      }
      WAVE_SYNC();
#pragma unroll
      for (int r = 0; r < ENTR; ++r) { srt[pos[r]] = ent[r]; sgt[pos[r]] = gt[r]; sut[pos[r]] = sue[r]; }
      WAVE_SYNC();
    }
    constexpr int NBQ = NSEL / 2;
    static_assert(NBQ % 4 == 0, "ring of four batches");
    f32x2 acc[NTW][2 * EW];
#pragma unroll
    for (int k = 0; k < NTW; ++k)
#pragma unroll
      for (int q = 0; q < 2 * EW; ++q) acc[k][q] = f32x2{0.f, 0.f};
    RowBatch A, B, C, D;
    auto ld = [&](RowBatch& X, int q) { gather4_load<true>(X, 2 * q, srt, lane, jr, ut, su, sv); };
    auto up = [&](const RowBatch& X, int q) { return gather4_u(X, 2 * q, hq, shl, sgt, sut, lane, jr); };
    auto vp = [&](const RowBatch& X, float cf) { gather4_v(X, cf, acc); };
    float cA, cB, cC, cD;
    ld(A, 0); ld(B, 1); ld(C, 2);
    cA = up(A, 0);
    for (int q = 0; q < NBQ - 4; q += 4) {
      if (CFG_GPACE && (q & UPM) == pstag) xcd_pace(pc);
      ld(D, q + 3);
      cB = up(B, q + 1); vp(A, cA); ld(A, q + 4);
      cC = up(C, q + 2); vp(B, cB); ld(B, q + 5);
      cD = up(D, q + 3); vp(C, cC); ld(C, q + 6);
      cA = up(A, q + 4); vp(D, cD);
    }
    ld(D, NBQ - 1);
    cB = up(B, NBQ - 3); vp(A, cA);
    cC = up(C, NBQ - 2); vp(B, cB);
    cD = up(D, NBQ - 1); vp(C, cC);
    vp(D, cD);
#pragma unroll
    for (int k = 0; k < NTW; ++k) {
      const int t = t0 + k;
      float hn[EPL]; float ss = 0.f;
#pragma unroll
      for (int q = 0; q < EW; ++q) {
        const f32x4 hv = *(const f32x4*)(hio + (size_t)t * DM + lane * EPL + 4 * q);
        hn[4 * q] = hv.x + acc[k][2 * q].x; hn[4 * q + 1] = hv.y + acc[k][2 * q].y; hn[4 * q + 2] = hv.z + acc[k][2 * q + 1].x; hn[4 * q + 3] = hv.w + acc[k][2 * q + 1].y;
      }
#pragma unroll
      for (int i = 0; i < EPL; ++i) ss += hn[i] * hn[i];
      ss = wave_sum(ss);
      const float rn = rsqrtf(ss * (1.0f / DM) + RMS_EPS);
      if (!g_act) {
      } else if (gfinal) {
#pragma unroll
        for (int q = 0; q < EW; ++q) {
          const f32x4 gv = *(const f32x4*)(gfinal + lane * EPL + 4 * q);
          *(f32x4*)(hio + (size_t)t * DM + lane * EPL + 4 * q) = f32x4{hn[4 * q] * rn * gv.x, hn[4 * q + 1] * rn * gv.y, hn[4 * q + 2] * rn * gv.z, hn[4 * q + 3] * rn * gv.w};
        }
      } else {
#pragma unroll
        for (int q = 0; q < EW; ++q) {
          *(f32x4*)(hio + (size_t)t * DM + lane * EPL + 4 * q) = f32x4{hn[4 * q], hn[4 * q + 1], hn[4 * q + 2], hn[4 * q + 3]};
          *(u32x2*)(hb + (size_t)t * DM + lane * EPL + 4 * q) = u32x2{pack2(hn[4 * q], hn[4 * q + 1]), pack2(hn[4 * q + 2], hn[4 * q + 3])};
        }
        if (lane == 0) rinv_next[t] = rn;
      }
    }
  }
}

constexpr int GLDW = 128 + 8;
DEVFN void ph_gmlp(const Params& P, const float* __restrict__ rinv_v, char* smem) {
  bf16_t* sW = (bf16_t*)smem;
  bf16_t* sVT = sW + 128 * GLDW;
  const bf16_t* __restrict__ pb = P.pb; const float* __restrict__ vg = P.in[23]; const float* __restrict__ bs = P.in[25];
  constexpr int NITEM = (T / 128) * NH;
  const int iters = (NITEM + gridDim.x - 1) / gridDim.x;
  const int tid = TIDX, lane = tid & 63, wv = tid >> 6, half = lane >> 5;
  int h_lds = -1;
  for (int it = 0; it < iters; ++it) {
    const int item = it * gridDim.x + blockIdx.x;
    const bool act = item < NITEM;
    const int h = item % NH, tok0 = (item / NH) * 128;
    __syncthreads();
    if (act) {
      if (h != h_lds) {
        h_lds = h;
        for (int e = tid; e < 128 * 16; e += NT) {
          const int row = e >> 4, c8 = (e & 15) * 8;
          *(u32x4*)(sW + row * GLDW + c8) = *(const u32x4*)(P.wsb + ((size_t)h * 128 + row) * 128 + c8);
        }
      }
      for (int e = tid; e < 128 * 8; e += NT) {
        const int sidx = e >> 3, d0 = (e & 7) * 8;
        const u32x4 w = *(const u32x4*)(pb + (size_t)(tok0 + sidx) * ODD_IN + AW + h * 64 + d0);
        const float ri = rinv_v[tok0 + sidx];
        const unsigned ws4[4] = {w.x, w.y, w.z, w.w};
#pragma unroll
        for (int j = 0; j < 4; ++j) {
          sVT[(d0 + 2 * j) * GLDW + sidx] = f2bf(gelu_f(bflo(ws4[j])) * ri * vg[h * 64 + d0 + 2 * j]);
          sVT[(d0 + 2 * j + 1) * GLDW + sidx] = f2bf(gelu_f(bfhi(ws4[j])) * ri * vg[h * 64 + d0 + 2 * j + 1]);
        }
      }
    }
    __syncthreads();
    if (!act) continue;
    const int mt = wv >> 1, nt = wv & 1;
    f32x16 acc;
#pragma unroll
    for (int r = 0; r < 16; ++r) acc[r] = 0.f;
    for (int ks = 0; ks < 2 * (mt + 1); ++ks) {
      const bf16x8 fa = *(const bf16x8*)(sW + (mt * 32 + (lane & 31)) * GLDW + ks * 16 + 8 * half);
      const bf16x8 fb = *(const bf16x8*)(sVT + (nt * 32 + (lane & 31)) * GLDW + ks * 16 + 8 * half);
      acc = mfma32(fa, fb, acc);
    }
    const int d = nt * 32 + (lane & 31);
#pragma unroll
    for (int r = 0; r < 16; ++r) {
      const int t = mt * 32 + (r & 3) + 8 * (r >> 2) + 4 * half;
      const float y = acc[r] + bs[h * 128 + t];
      const float u = gelu_f(bf2f(pb[(size_t)(tok0 + t) * ODD_IN + h * 64 + d]));
      P.cb[(size_t)(tok0 + t) * DM + h * 64 + d] = f2bf(u * y);
    }
  }
}

constexpr float SB_EXIT = -40.0f;
constexpr int VLD = 40;
DEVFN void ph_sbattn(const Params& P, char* smem) {
  const int tid = TIDX, lane = tid & 63, wv = tid >> 6, half = lane >> 5, l31 = lane & 31;
  bf16_t* vtp = (bf16_t*)(smem + wv * (64 * VLD * 2));
  constexpr int NQB = SEQ / 32;
  const bf16_t* __restrict__ pb = P.pb;
  for (int item = blockIdx.x * NWV + wv; item < NB * NH * NQB; item += gridDim.x * NWV) {
    const int qb = item % NQB, h = (item / NQB) % NH, b = item / (NQB * NH);
    const size_t tokb = (size_t)b * SEQ;
    bf16x8 qf[4];
    {
      const bf16_t* qp = pb + (tokb + qb * 32 + l31) * ODD_IN + 2 * AW + h * 64 + 8 * half;
#pragma unroll
      for (int s = 0; s < 4; ++s) qf[s] = *(const bf16x8*)(qp + 16 * s);
    }
    f32x16 oacc[2];
#pragma unroll
    for (int n = 0; n < 2; ++n)
#pragma unroll
      for (int r = 0; r < 16; ++r) oacc[n][r] = 0.f;
    float R = 0.f;
    const int qpos = qb * 32 + l31;
    for (int kt = qb; kt >= 0; --kt) {
      bf16x8 kf[4];
      {
        const bf16_t* kp = pb + (tokb + kt * 32 + l31) * ODD_IN + 3 * AW + h * 64 + 8 * half;
#pragma unroll
        for (int s = 0; s < 4; ++s) kf[s] = *(const bf16x8*)(kp + 16 * s);
      }
      WAVE_SYNC();
#pragma unroll
      for (int i = 0; i < 4; ++i) {
        const int c = lane + 64 * i, key = c >> 3, d0 = (c & 7) * 8;
        const u32x4 w = *(const u32x4*)(pb + (tokb + kt * 32 + key) * ODD_IN + 4 * AW + h * 64 + d0);
        const int slot = (key & 16) + 8 * ((key >> 2) & 1) + 4 * ((key >> 3) & 1) + (key & 3);
        const unsigned ws4[4] = {w.x, w.y, w.z, w.w};
#pragma unroll
        for (int j = 0; j < 4; ++j) {
          vtp[(d0 + 2 * j) * VLD + slot] = (bf16_t)(ws4[j] & 0xffffu);
          vtp[(d0 + 2 * j + 1) * VLD + slot] = (bf16_t)(ws4[j] >> 16);
        }
      }
      WAVE_SYNC();
      f32x16 z;
#pragma unroll
      for (int r = 0; r < 16; ++r) z[r] = 0.f;
#pragma unroll
      for (int s = 0; s < 4; ++s) z = mfma32(kf[s], qf[s], z);
      float lp[16], la[16];
#pragma unroll
      for (int r = 0; r < 16; ++r) {
        const int kpos = kt * 32 + (r & 3) + 8 * (r >> 2) + 4 * half;
        const bool valid = kpos < qpos;
        const float zz = z[r] * 0.125f;
        const float sp = fmaxf(zz, 0.f) + __logf(1.0f + __expf(-fabsf(zz)));
        lp[r] = valid ? -sp : 0.f;
        la[r] = valid ? zz - sp : -1.0e30f;
      }
      float e[16], tot[4], pt[4];
#pragma unroll
      for (int c = 0; c < 4; ++c) {
        e[4 * c + 3] = 0.f; e[4 * c + 2] = lp[4 * c + 3]; e[4 * c + 1] = e[4 * c + 2] + lp[4 * c + 2]; e[4 * c] = e[4 * c + 1] + lp[4 * c + 1];
        tot[c] = e[4 * c] + lp[4 * c];
      }
#pragma unroll
      for (int c = 0; c < 4; ++c) pt[c] = partner32(tot[c]);
      float G[8];
      G[7] = 0.f;
#pragma unroll
      for (int g = 6; g >= 0; --g) {
        const int c = (g + 1) >> 1;
        const bool odd = (g + 1) & 1;
        const float tg = odd ? (half ? tot[c] : pt[c]) : (half ? pt[c] : tot[c]);
        G[g] = G[g + 1] + tg;
      }
      const float total = G[0] + (half ? pt[0] : tot[0]);
      float w[16];
#pragma unroll
      for (int r = 0; r < 16; ++r) {
        const int c = r >> 2;
        const float gown = half ? G[2 * c + 1] : G[2 * c];
        w[r] = __expf(la[r] + R + gown + e[r]);
      }
      R += total;
#pragma unroll
      for (int s = 0; s < 2; ++s) {
        bf16x8 fa;
#pragma unroll
        for (int j = 0; j < 8; ++j) fa[j] = (short)f2bf(w[8 * s + j]);
#pragma unroll
        for (int n = 0; n < 2; ++n) {
          const bf16x8 fb = *(const bf16x8*)(vtp + (n * 32 + l31) * VLD + 16 * s + 8 * half);
          oacc[n] = mfma32(fa, fb, oacc[n]);
        }
      }
      if (__all(R < SB_EXIT)) break;
    }
#pragma unroll
    for (int n = 0; n < 2; ++n)
#pragma unroll
      for (int r = 0; r < 16; ++r) {
        const int row = (r & 3) + 8 * (r >> 2) + 4 * half;
        P.cb[(tokb + qb * 32 + row) * DM + AW + h * 64 + n * 32 + l31] = f2bf(oacc[n][r]);
      }
  }
}

#ifdef HOST_EMU
int emu_stage = 0;
#define EMU_STOP(n) if (emu_stage == n) return
#else
#define EMU_STOP(n)
#endif
__global__ void __launch_bounds__(NT) fwd_megakernel(Params P) {
  DECL_SMEM(smem, SMEM_BYTES);
#ifdef HOST_EMU
  const XcdBarrier xb{0};
#endif
#ifndef HOST_EMU
  if (threadIdx.x == 0) *(u32x4*)(smem + SMEM_BYTES - 16) = u32x4{0u, 0u, 0u, 0u};
  __syncthreads();
  const XcdBarrier xb = xcd_barrier_post(P.bar, (volatile LAS unsigned*)(smem + SMEM_BYTES - 16));
#endif
  const float* x = P.in[0];
  ph_prep(P, smem);
  GRID_SYNC();
  GEMM_SCALE(P.hb, P.wt_in0, DM, EVEN_IN, P.rinv, P.pb);
  XSYNC();
  ph_s5_pass1(P);
  ph_conv(P);
  XSYNC();
  ph_s5_pass2(P);
  {
    const int tidx[4] = {19, 20, 31, 32};
#pragma unroll
    for (int i = 0; i < 4; ++i) { if ((i & 1) == 0) prep_tab_i4(P.in[tidx[i]], P.tabs[i], P.tscale[i]); else prep_tab_fp4(P.in[tidx[i]], P.tabs[i - 1], P.tscale[i]); }
  }
  XSYNC();
  ph_s5_pass3(P, smem);
  XSYNC();
  GEMM_GLU(P.ya, P.wt_glu, AW, AW, P.ya, P.in[12], P.cb);
  XSYNC();
  GEMM_RES(P.cb, P.wt_out0, DM, DM, x, P.hout, P.hb);
  XSYNC();
  EMU_STOP(1);
  GEMM_SCALE(P.hb, P.wt_q0, DM, QN, (const float*)nullptr, P.pb);
  XSYNC();
  ph_topk(P.pb, P.keys[0], P.keys[1], P.idx, P.gate, smem);
  XSYNC();
  ph_gather4(P.hout, P.in[15], P.idx, P.gate, P.tabs[0], P.tabs[1], P.tscale[0], P.tscale[1], P.hb, P.rinv2, nullptr, smem, xb, 0);
  XSYNC();
  EMU_STOP(2);
  GEMM_SCALE(P.hb, P.wt_in1, DM, ODD_IN, P.rinv2, P.pb);
  XSYNC();
  rowstat_v(P.pb, P.rinv);
  XSYNC();
  ph_gmlp(P, P.rinv, smem);
  __syncthreads();
  __syncthreads();
  ph_sbattn(P, smem);
  XSYNC();
  GEMM_RES(P.cb, P.wt_out1, DM, DM, P.hout, P.hout, P.hb);
  XSYNC();
  EMU_STOP(3);
  GEMM_SCALE(P.hb, P.wt_q1, DM, QN, (const float*)nullptr, P.pb);
  XSYNC();
  ph_topk(P.pb, P.keys[2], P.keys[3], P.idx, P.gate, smem);
  XSYNC();
  ph_gather4(P.hout, P.in[27], P.idx, P.gate, P.tabs[2], P.tabs[3], P.tscale[2], P.tscale[3], P.hb, P.rinv2, P.in[33], smem, xb, 1);
}

static inline size_t align_up(size_t x) { return (x + 255) & ~(size_t)255; }

extern "C" void kernel_launch(void* const* d_in, const int* in_sizes, int n_in, void* d_out, int out_size, void* d_ws, size_t ws_size, hipStream_t stream) {
  (void)in_sizes; (void)n_in; (void)out_size; (void)ws_size;
  Params P{};
  for (int i = 0; i < 34; ++i) P.in[i] = (const float*)d_in[i];
  P.hout = (float*)d_out;
  char* ws = (char*)d_ws; size_t off = 0;
  auto carve = [&](size_t bytes) { char* p = ws + off; off = align_up(off + bytes); return p; };
  P.wt_in0 = (bf16_t*)carve((size_t)EVEN_IN * DM * 2);
  P.wt_glu = (bf16_t*)carve((size_t)AW * AW * 2);
  P.wt_out0 = (bf16_t*)carve((size_t)DM * DM * 2);
  P.wt_q0 = (bf16_t*)carve((size_t)QN * DM * 2);
  P.wt_in1 = (bf16_t*)carve((size_t)ODD_IN * DM * 2);
  P.wt_out1 = (bf16_t*)carve((size_t)DM * DM * 2);
  P.wt_q1 = (bf16_t*)carve((size_t)QN * DM * 2);
  for (int i = 0; i < 4; ++i) P.keys[i] = (bf16_t*)carve((size_t)PH * NKEY * 128 * 2);
  for (int i = 0; i < 4; ++i) P.tabs[i] = (unsigned char*)carve((size_t)NEXP * DM);
  for (int i = 0; i < 4; ++i) P.tscale[i] = (float*)carve((size_t)NEXP * 4);
  P.hb = (bf16_t*)carve((size_t)T * DM * 2);
  P.pb = (bf16_t*)carve((size_t)T * ODD_IN * 2);
  P.cb = (bf16_t*)carve((size_t)T * DM * 2);
  P.idx = (int*)carve((size_t)T * NSEL * 4);
  P.gate = (float*)carve((size_t)T * NSEL * 4);
  if constexpr ((size_t)AW * 2 <= (size_t)NSEL * 8) P.ya = (bf16_t*)P.idx;
  else P.ya = (bf16_t*)carve((size_t)T * AW * 2);
  P.S = (float*)carve((size_t)NB * NCH * NG * 128 * 4);
  P.S2 = (float*)carve((size_t)NB * NCH * NG * 128 * 4);
  P.rinv = (float*)carve((size_t)T * 4);
  P.rinv2 = (float*)carve((size_t)T * 4);
  P.bar = (unsigned*)carve(XCD_BAR_WORDS * 4);
  P.wsb = (bf16_t*)carve((size_t)NH * 128 * 128 * 2);
  P.tb.ar = (float*)carve(NG * 64 * 4); P.tb.ai = (float*)carve(NG * 64 * 4); P.tb.aqr = (float*)carve(NG * 64 * 4); P.tb.aqi = (float*)carve(NG * 64 * 4);
  P.tb.a16r = (float*)carve(NG * 64 * 4); P.tb.a16i = (float*)carve(NG * 64 * 4);
  P.tb.bbT = (bf16_t*)carve((size_t)NG * 128 * 16 * 2); P.tb.cmP = (bf16_t*)carve((size_t)NG * 16 * CMK * 2);
#ifdef HOST_EMU
  if (off > ws_size) { fprintf(stderr, "ws too small: need %zu have %zu\n", off, ws_size); abort(); }
  emu::launch(dim3(getenv("EMU_GRID") ? atoi(getenv("EMU_GRID")) : 3), dim3(NT), [=]() { fwd_megakernel(P); }, true);
#else
  static int grid_blocks = 0;
  if (!grid_blocks) {
    int dev = 0, cus = 0, per_cu = 0;
    hipGetDevice(&dev);
    hipDeviceGetAttribute(&cus, hipDeviceAttributeMultiprocessorCount, dev);
    hipOccupancyMaxActiveBlocksPerMultiprocessor(&per_cu, fwd_megakernel, NT, 0);
    if (per_cu > 1) per_cu = 1;
    grid_blocks = cus * per_cu;
  }
  (void)hipMemsetAsync(P.bar, 0, XCD_BAR_WORDS * 4, stream);
  void* args[] = {&P};
  hipError_t e = hipLaunchCooperativeKernel((void*)fwd_megakernel, dim3(grid_blocks), dim3(NT), args, 0, stream);
  if (e != hipSuccess) fprintf(stderr, "cooperative launch failed: %s (grid %d)\n", hipGetErrorString(e), grid_blocks);
#endif
}
```

```cpp
#ifndef HOST_EMU
#include <hip/hip_runtime.h>
#include <hip/hip_cooperative_groups.h>
#include <cstdio>
#define DECL_SMEM(name, bytes) __shared__ __attribute__((aligned(16))) char name[bytes]
#define GRID_SYNC() cooperative_groups::this_grid().sync()
#define WAVE_SYNC() do { __builtin_amdgcn_fence(__ATOMIC_RELEASE, "wavefront"); __builtin_amdgcn_wave_barrier(); __builtin_amdgcn_fence(__ATOMIC_ACQUIRE, "wavefront"); } while (0)
#else
#define DECL_SMEM(name, bytes) char* name = emu::smem(bytes)
#define GRID_SYNC() emu_grid_sync()
#define WAVE_SYNC() emu::sync(emu::ST_WAVE)
#endif
#include <utility>
#define DEVFN __device__ __forceinline__
#ifndef HOST_EMU
#define OPAQUE(x) asm volatile("" : "+v"(x))
#else
#define OPAQUE(x) asm volatile("" : "+r"(x))
#endif

#ifndef CFG_DM
#define CFG_DM 1024
#define CFG_SEQ 16384
#define CFG_PH 8
#endif

typedef unsigned short bf16_t;
typedef short bf16x8 __attribute__((ext_vector_type(8)));
typedef float f32x16 __attribute__((ext_vector_type(16)));
typedef unsigned u32x4 __attribute__((ext_vector_type(4)));
typedef unsigned u32x2 __attribute__((ext_vector_type(2)));
typedef float f32x4 __attribute__((ext_vector_type(4)));

constexpr int DM = CFG_DM, SEQ = CFG_SEQ, NB = 2, T = NB * SEQ;
constexpr int AW = DM / 2;
constexpr int EVEN_IN = 4 * AW, ODD_IN = 5 * AW;
constexpr int NG = AW / 16, NST = 64;
constexpr int NH = AW / 64;
constexpr int PH = CFG_PH, QN = PH * 256;
constexpr int NKEY = 128, NEXP = NKEY * NKEY, TOPK = 16, NSEL = PH * TOPK;
constexpr int SQ = 64, NCH = SEQ / SQ;
constexpr float RMS_EPS = 1e-6f;

DEVFN float bf2f(bf16_t h) { return __builtin_bit_cast(float, (unsigned)h << 16); }
DEVFN bf16_t f2bf(float f) { unsigned u = __builtin_bit_cast(unsigned, f); u += 0x7fffu + ((u >> 16) & 1u); return (bf16_t)(u >> 16); }
DEVFN float bflo(unsigned w) { return __builtin_bit_cast(float, w << 16); }
DEVFN float bfhi(unsigned w) { return __builtin_bit_cast(float, w & 0xffff0000u); }
DEVFN unsigned pack2(float lo, float hi) { return (unsigned)f2bf(lo) | ((unsigned)f2bf(hi) << 16); }
DEVFN float sigmoid_f(float x) { return 1.0f / (1.0f + __expf(-x)); }
DEVFN float gelu_f(float x) { float u = 1.5957691216057308f * (x + 0.044715f * x * x * x); return x / (1.0f + __expf(-u)); }
DEVFN void swap32(float& a, float& b) {
#ifndef HOST_EMU
  asm volatile("v_nop\n\tv_nop\n\tv_permlane32_swap_b32 %0, %1" : "+v"(a), "+v"(b));
#else
  const int lane = emu::cur % 64; const float xa = __shfl(a, lane ^ 32), xb = __shfl(b, lane ^ 32);
  if (lane < 32) b = xa; else a = xb;
#endif
}
DEVFN void swap16(float& a, float& b) {
#ifndef HOST_EMU
  asm volatile("v_nop\n\tv_nop\n\tv_permlane16_swap_b32 %0, %1" : "+v"(a), "+v"(b));
#else
  const int lane = emu::cur % 64; const float xa = __shfl(a, lane ^ 16), xb = __shfl(b, lane ^ 16);
  if ((lane & 16) == 0) b = xa; else a = xb;
#endif
}
template <int CTRL> DEVFN float dpp_f(float v) {
#ifndef HOST_EMU
  return __builtin_bit_cast(float, __builtin_amdgcn_update_dpp(0, __builtin_bit_cast(int, v), CTRL, 0xf, 0xf, true));
#else
  const int lane = emu::cur % 64;
  const int srcl = CTRL == 0x128 ? (lane ^ 8) : CTRL == 0x141 ? ((lane & ~7) | (7 - (lane & 7))) : CTRL == 0xB1 ? (lane ^ 1) : (lane ^ 2);
  return __shfl(v, srcl);
#endif
}

DEVFN float partner32(float v) { float a = v, b = v; swap32(a, b); return (threadIdx.x & 32) ? a : b; }
DEVFN float row16_sum(float v) { v += dpp_f<0xB1>(v); v += dpp_f<0x4E>(v); v += dpp_f<0x141>(v); v += dpp_f<0x128>(v); return v; }
DEVFN float row16_max(float v) { v = fmaxf(v, dpp_f<0xB1>(v)); v = fmaxf(v, dpp_f<0x4E>(v)); v = fmaxf(v, dpp_f<0x141>(v)); v = fmaxf(v, dpp_f<0x128>(v)); return v; }
DEVFN float wave_sum(float v) {
  v += dpp_f<0xB1>(v); v += dpp_f<0x4E>(v); v += dpp_f<0x141>(v); v += dpp_f<0x128>(v);
  { float a = v, b = v; swap16(a, b); v += (threadIdx.x & 16) ? a : b; }
  { float a = v, b = v; swap32(a, b); v += (threadIdx.x & 32) ? a : b; }
  return v;
}
DEVFN f32x16 mfma32(bf16x8 a, bf16x8 b, f32x16 c) {
#ifndef HOST_EMU
  return __builtin_amdgcn_mfma_f32_32x32x16_bf16(a, b, c, 0, 0, 0);
#else
  return emu_mfma32x32x16(a, b, c);
#endif
}


typedef float f32x2 __attribute__((ext_vector_type(2)));
#ifdef HOST_EMU
static inline unsigned emu_f2e4m3(float x) {
  unsigned s = (x < 0.f || (x == 0.f && std::signbit(x))) ? 0x80u : 0u; float a = fabsf(x);
  if (!(a == a)) return s | 0x7f;
  if (a >= 464.f) return s | 0x7e;
  if (a < 0.0009765625f) return s;
  int e; float m = frexpf(a, &e); e -= 1; m *= 2.f;
  if (e < -6) { float q = a * 512.f; float r = nearbyintf(q); unsigned mi = (unsigned)r; return s | mi; }
  float q = (m - 1.f) * 8.f; float r = nearbyintf(q); unsigned mi = (unsigned)r;
  if (mi == 8) { mi = 0; e += 1; }
  unsigned code = ((unsigned)(e + 7) << 3) | mi; if (code > 0x7e) code = 0x7e;
  return s | code;
}
static inline float emu_e4m32f(unsigned c) {
  float sgn = (c & 0x80) ? -1.f : 1.f; unsigned E = (c >> 3) & 15, m = c & 7;
  float v = E == 0 ? (m / 8.f) * 0.015625f : (1.f + m / 8.f) * ldexpf(1.f, (int)E - 7);
  return sgn * v;
}
#endif
DEVFN unsigned pack_fp8x4(float a, float b, float c, float d) {
#ifndef HOST_EMU
  int w = 0;
  w = __builtin_amdgcn_cvt_pk_fp8_f32(a, b, w, false);
  w = __builtin_amdgcn_cvt_pk_fp8_f32(c, d, w, true);
  return (unsigned)w;
#else
  return emu_f2e4m3(a) | (emu_f2e4m3(b) << 8) | (emu_f2e4m3(c) << 16) | (emu_f2e4m3(d) << 24);
#endif
}
DEVFN f32x2 unpack_fp8_lo(unsigned w) {
#ifndef HOST_EMU
  return __builtin_amdgcn_cvt_pk_f32_fp8((int)w, false);
#else
  return f32x2{emu_e4m32f(w & 255), emu_e4m32f((w >> 8) & 255)};
#endif
}
DEVFN f32x2 unpack_fp8_hi(unsigned w) {
#ifndef HOST_EMU
  return __builtin_amdgcn_cvt_pk_f32_fp8((int)w, true);
#else
  return f32x2{emu_e4m32f((w >> 16) & 255), emu_e4m32f(w >> 24)};
#endif
}

DEVFN int sdot4(int a, int b, int c) {
#ifndef HOST_EMU
  return __builtin_amdgcn_sdot4(a, b, c, false);
#else
  for (int i = 0; i < 4; ++i) c += (int)(signed char)(a >> (8 * i)) * (int)(signed char)(b >> (8 * i));
  return c;
#endif
}
DEVFN int sdot8(int a, int b, int c) {
#ifndef HOST_EMU
  return __builtin_amdgcn_sdot8(a, b, c, false);
#else
  for (int i = 0; i < 8; ++i) c += ((a << (28 - 4 * i)) >> 28) * ((b << (28 - 4 * i)) >> 28);
  return c;
#endif
}
DEVFN unsigned pack_i8x4(float a, float b, float c, float d) {
  return ((unsigned)(int)rintf(a) & 255u) | (((unsigned)(int)rintf(b) & 255u) << 8) | (((unsigned)(int)rintf(c) & 255u) << 16) | (((unsigned)(int)rintf(d) & 255u) << 24);
}
#ifdef HOST_EMU
static inline unsigned emu_f2e2m1(float x) {
  unsigned s = (x < 0.f || (x == 0.f && std::signbit(x))) ? 8u : 0u; float a = fabsf(x);
  static const float grid[8] = {0.f, 0.5f, 1.f, 1.5f, 2.f, 3.f, 4.f, 6.f};
  unsigned best = 0; float bd = 1e30f;
  for (unsigned i = 0; i < 8; ++i) { float d = fabsf(a - grid[i]); if (d < bd || (d == bd && (i & 1) == 0)) { bd = d; best = i; } }
  return s | best;
}
static inline float emu_e2m12f(unsigned c) { static const float grid[8] = {0.f, 0.5f, 1.f, 1.5f, 2.f, 3.f, 4.f, 6.f}; return ((c & 8) ? -1.f : 1.f) * grid[c & 7]; }
#endif
DEVFN unsigned pack_fp4x8(const float (&x)[8]) {
#ifndef HOST_EMU
  unsigned w = 0;
  w = __builtin_amdgcn_cvt_scalef32_pk_fp4_f32(w, x[0], x[1], 1.0f, 0);
  w = __builtin_amdgcn_cvt_scalef32_pk_fp4_f32(w, x[2], x[3], 1.0f, 1);
  w = __builtin_amdgcn_cvt_scalef32_pk_fp4_f32(w, x[4], x[5], 1.0f, 2);
  w = __builtin_amdgcn_cvt_scalef32_pk_fp4_f32(w, x[6], x[7], 1.0f, 3);
  return w;
#else
  unsigned w = 0;
  for (int i = 0; i < 8; ++i) w |= emu_f2e2m1(x[i]) << (4 * i);
  return w;
#endif
}
template <int BYTE> DEVFN f32x2 unpack_fp4(unsigned w) {
#ifndef HOST_EMU
  return __builtin_amdgcn_cvt_scalef32_pk_f32_fp4(w, 1.0f, BYTE);
#else
  return f32x2{emu_e2m12f((w >> (8 * BYTE)) & 15), emu_e2m12f((w >> (8 * BYTE + 4)) & 15)};
#endif
}
DEVFN float bcast_lane(float v, int srclane) {
#ifndef HOST_EMU
  return __builtin_bit_cast(float, __builtin_amdgcn_readlane(__builtin_bit_cast(int, v), srclane));
#else
  return __shfl(v, srclane);
#endif
}
DEVFN int bcast_lane_i(int v, int srclane) {
#ifndef HOST_EMU
  return __builtin_amdgcn_readlane(v, srclane);
#else
  return __shfl(v, srclane);
#endif
}

DEVFN int opaque_tid() { int t = threadIdx.x; OPAQUE(t); return t; }
#define TIDX opaque_tid()

DEVFN unsigned long long wave_ballot(bool p) {
#ifndef HOST_EMU
  return __builtin_amdgcn_ballot_w64(p);
#else
  return __ballot(p ? 1 : 0);
#endif
}
DEVFN int mbcnt64(unsigned long long m, int lane) {
#ifndef HOST_EMU
  return (int)__builtin_amdgcn_mbcnt_hi((unsigned)(m >> 32), __builtin_amdgcn_mbcnt_lo((unsigned)m, 0u));
#else
  return __builtin_popcountll(m & ((1ull << lane) - 1ull));
#endif
}


constexpr int NT = 512, NWV = NT / 64;
constexpr int SMEM_BYTES = 160 * 1024;

struct S5Tab { float* ar; float* ai; float* aqr; float* aqi; float* a16r; float* a16i; bf16_t* bbT; bf16_t* cmP; };
struct Params {
  const float* in[34];
  float* hout;
  bf16_t* wt_in0; bf16_t* wt_glu; bf16_t* wt_out0; bf16_t* wt_q0; bf16_t* wt_in1; bf16_t* wt_out1; bf16_t* wt_q1;
  bf16_t* keys[4]; unsigned char* tabs[4]; float* tscale[4];
  bf16_t* hb; bf16_t* pb; bf16_t* cb; bf16_t* ya;
  int* idx; float* gate;
  float* S; float* S2; float* rinv; float* rinv2;
  S5Tab tb;
  unsigned* bar;
  bf16_t* wsb;
};

DEVFN void prep_wt(const float* __restrict__ W, const float* __restrict__ g, bf16_t* __restrict__ Wt, int K, int N, char* smem) {
  const int sub = TIDX >> 8, stid = TIDX & 255;
  float* tile = (float*)(smem + sub * (64 * 65 * 4));
  const int ntn = N / 64, ntiles = (K / 64) * ntn;
  const int stride = gridDim.x * 2;
  const int iters = (ntiles + stride - 1) / stride;
  for (int it = 0; it < iters; ++it) {
    const int vb = (it * gridDim.x + blockIdx.x) * 2 + sub;
    const bool act = vb < ntiles;
    const int k0 = (vb / ntn) * 64, n0 = (vb % ntn) * 64;
    __syncthreads();
    if (act)
      for (int e = stid; e < 64 * 64; e += 256) {
        int i = e >> 6, j = e & 63;
        float gv = g ? g[k0 + i] : 1.0f;
        tile[i * 65 + j] = W[(size_t)(k0 + i) * N + n0 + j] * gv;
      }
    __syncthreads();
    if (act)
      for (int e = stid; e < 64 * 64; e += 256) {
        int j = e >> 6, i = e & 63;
        Wt[(size_t)(n0 + j) * K + k0 + i] = f2bf(tile[i * 65 + j]);
      }
  }
}
DEVFN void cvt_bf16(const float* __restrict__ src, bf16_t* __restrict__ dst, size_t n4) {
  for (size_t i = (size_t)blockIdx.x * NT + TIDX; i < n4; i += (size_t)gridDim.x * NT) {
    f32x4 v = ((const f32x4*)src)[i];
    ((u32x2*)dst)[i] = u32x2{pack2(v.x, v.y), pack2(v.z, v.w)};
  }
}
constexpr int CMK = 144;
DEVFN void prep_s5(const Params& P) {
  for (int gid = blockIdx.x * NT + TIDX; gid < NG * NST; gid += gridDim.x * NT) {
  const int gp = gid, g = gid / NST, p = gid % NST;
  const float* lam_re = P.in[3]; const float* lam_im = P.in[4]; const float* log_dt = P.in[5];
  const float* b_re = P.in[6]; const float* b_im = P.in[7];
  const float* c_re = P.in[8]; const float* c_im = P.in[9]; const float* dsk = P.in[10];
  const S5Tab& tb = P.tb;
  const float dt = __expf(log_dt[g]);
  const float lr = lam_re[gp], li = lam_im[gp];
  const float mag = __expf(lr * dt);
  const float ar = mag * cosf(li * dt), ai = mag * sinf(li * dt);
  const float den = lr * lr + li * li;
  const float nr = ar - 1.0f;
  const float fr = (nr * lr + ai * li) / den, fi = (ai * lr - nr * li) / den;
  tb.ar[gp] = ar; tb.ai[gp] = ai;
  float qr = ar, qi = ai;
#pragma unroll
  for (int sq = 0; sq < 6; ++sq) {
    float nr2 = qr * qr - qi * qi, ni2 = 2.0f * qr * qi; qr = nr2; qi = ni2;
    if (sq == 3) { tb.a16r[gp] = qr; tb.a16i[gp] = qi; }
  }
  tb.aqr[gp] = qr; tb.aqi[gp] = qi;
  const int c = p & 31, hi = p >> 5;
  for (int ci = 0; ci < 16; ++ci) {
    const float br = b_re[gp * 16 + ci], bi = b_im[gp * 16 + ci];
    tb.bbT[((size_t)g * 128 + (0 + hi) * 32 + c) * 16 + ci] = f2bf(fr * br - fi * bi);
    tb.bbT[((size_t)g * 128 + (2 + hi) * 32 + c) * 16 + ci] = f2bf(fr * bi + fi * br);
  }
  for (int co = 0; co < 16; ++co) {
    tb.cmP[((size_t)g * 16 + co) * CMK + 4 * c + 2 * hi + 0] = f2bf(c_re[((size_t)g * 16 + co) * NST + p]);
    tb.cmP[((size_t)g * 16 + co) * CMK + 4 * c + 2 * hi + 1] = f2bf(-c_im[((size_t)g * 16 + co) * NST + p]);
    if (p < 16) tb.cmP[((size_t)g * 16 + co) * CMK + 128 + p] = (p == co) ? f2bf(dsk[g * 16 + co]) : (bf16_t)0;
  }
  }
}
DEVFN void rowstat(const float* __restrict__ h, float* __restrict__ rinv, bf16_t* __restrict__ hb) {
  const int lane = TIDX & 63;
  for (int t = blockIdx.x * NWV + (TIDX >> 6); t < T; t += gridDim.x * NWV) {
    const float* row = h + (size_t)t * DM;
    float ss = 0.f;
#pragma unroll
    for (int i = 0; i < DM / 256; ++i) {
      f32x4 v = ((const f32x4*)row)[i * 64 + lane];
      ss += v.x * v.x + v.y * v.y + v.z * v.z + v.w * v.w;
      if (hb) ((u32x2*)(hb + (size_t)t * DM))[i * 64 + lane] = u32x2{pack2(v.x, v.y), pack2(v.z, v.w)};
    }
    ss = wave_sum(ss);
    if (lane == 0) rinv[t] = rsqrtf(ss * (1.0f / DM) + RMS_EPS);
  }
}
DEVFN void rowstat_v(const bf16_t* __restrict__ pb, float* __restrict__ rinv_v) {
  const int lane = TIDX & 63;
  for (int t = blockIdx.x * NWV + (TIDX >> 6); t < T; t += gridDim.x * NWV) {
    const bf16_t* row = pb + (size_t)t * ODD_IN + AW;
    float ss = 0.f;
    for (int c = lane; c < AW; c += 64) { float v = gelu_f(bf2f(row[c])); ss += v * v; }
    ss = wave_sum(ss);
    if (lane == 0) rinv_v[t] = rsqrtf(ss * (1.0f / AW) + RMS_EPS);
  }
}
constexpr int EPL = DM / 64;
constexpr int EW = EPL / 4;
DEVFN void prep_tab_fp8(const float* __restrict__ src, unsigned char* __restrict__ dst, float* __restrict__ scale) {
  const int lane = TIDX & 63;
  for (int r = blockIdx.x * NWV + (TIDX >> 6); r < NEXP; r += gridDim.x * NWV) {
    float v[EPL];
#pragma unroll
    for (int k = 0; k < EW; ++k) { f32x4 x = *(const f32x4*)(src + (size_t)r * DM + lane * EPL + 4 * k); v[4 * k] = x.x; v[4 * k + 1] = x.y; v[4 * k + 2] = x.z; v[4 * k + 3] = x.w; }
    float mx = 0.f;
#pragma unroll
    for (int i = 0; i < EPL; ++i) mx = fmaxf(mx, fabsf(v[i]));
    mx = row16_max(mx);
    { float a = mx, b = mx; swap16(a, b); mx = fmaxf(mx, (threadIdx.x & 16) ? a : b); }
    mx = fmaxf(mx, partner32(mx));
    mx = fmaxf(mx, 1e-30f);
    const float inv = 224.0f / mx;
    unsigned w[EW];
#pragma unroll
    for (int k = 0; k < EW; ++k) w[k] = pack_fp8x4(v[4 * k] * inv, v[4 * k + 1] * inv, v[4 * k + 2] * inv, v[4 * k + 3] * inv);
    if constexpr (EW == 4) *(u32x4*)(dst + (size_t)r * DM + lane * EPL) = u32x4{w[0], w[1], w[2], w[3]};
    else *(u32x2*)(dst + (size_t)r * DM + lane * EPL) = u32x2{w[0], w[1]};
    if (lane == 0) scale[r] = mx * (1.0f / 224.0f);
  }
}
DEVFN void prep_tab_i8(const float* __restrict__ src, unsigned char* __restrict__ dst, float* __restrict__ scale) {
  const int lane = TIDX & 63;
  for (int r = blockIdx.x * NWV + (TIDX >> 6); r < NEXP; r += gridDim.x * NWV) {
    float v[EPL];
#pragma unroll
    for (int k = 0; k < EW; ++k) { f32x4 x = *(const f32x4*)(src + (size_t)r * DM + lane * EPL + 4 * k); v[4 * k] = x.x; v[4 * k + 1] = x.y; v[4 * k + 2] = x.z; v[4 * k + 3] = x.w; }
    float mx = 0.f;
#pragma unroll
    for (int i = 0; i < EPL; ++i) mx = fmaxf(mx, fabsf(v[i]));
    mx = row16_max(mx);
    { float a = mx, b = mx; swap16(a, b); mx = fmaxf(mx, (threadIdx.x & 16) ? a : b); }
    mx = fmaxf(mx, partner32(mx));
    mx = fmaxf(mx, 1e-30f);
    const float inv = 127.0f / mx;
    unsigned w[EW];
#pragma unroll
    for (int k = 0; k < EW; ++k) w[k] = pack_i8x4(v[4 * k] * inv, v[4 * k + 1] * inv, v[4 * k + 2] * inv, v[4 * k + 3] * inv);
    if constexpr (EW == 4) *(u32x4*)(dst + (size_t)r * DM + lane * EPL) = u32x4{w[0], w[1], w[2], w[3]};
    else *(u32x2*)(dst + (size_t)r * DM + lane * EPL) = u32x2{w[0], w[1]};
    if (lane == 0) scale[r] = mx * (1.0f / 127.0f);
  }
}
constexpr int U4W = EW / 2;
static_assert(EW % 2 == 0, "int4 u rows need EPL to be a multiple of 8");
DEVFN void prep_tab_i4(const float* __restrict__ src, unsigned char* __restrict__ dst, float* __restrict__ scale) {
  const int lane = TIDX & 63;
  for (int r = blockIdx.x * NWV + (TIDX >> 6); r < NEXP; r += gridDim.x * NWV) {
    float v[EPL];
#pragma unroll
    for (int k = 0; k < EW; ++k) { f32x4 x = *(const f32x4*)(src + (size_t)r * DM + lane * EPL + 4 * k); v[4 * k] = x.x; v[4 * k + 1] = x.y; v[4 * k + 2] = x.z; v[4 * k + 3] = x.w; }
    float mx = 0.f;
#pragma unroll
    for (int i = 0; i < EPL; ++i) mx = fmaxf(mx, fabsf(v[i]));
    mx = row16_max(mx);
    { float a = mx, b = mx; swap16(a, b); mx = fmaxf(mx, (threadIdx.x & 16) ? a : b); }
    mx = fmaxf(mx, partner32(mx));
    mx = fmaxf(mx, 1e-30f);
    const float inv = 7.0f / mx;
    unsigned w[U4W];
#pragma unroll
    for (int g = 0; g < U4W; ++g) {
      w[g] = 0u;
#pragma unroll
      for (int k = 0; k < 8; ++k) w[g] |= ((unsigned)(int)rintf(v[8 * g + k] * inv) & 15u) << (4 * k);
    }
    if constexpr (U4W == 2) *(u32x2*)(dst + (size_t)r * DM + lane * EPL) = u32x2{w[0], w[1]};
    else *(unsigned*)(dst + (size_t)r * DM + lane * EPL) = w[0];
    if (lane == 0) scale[2 * r] = mx * (1.0f / 7.0f);
  }
}
DEVFN void prep_tab_fp4(const float* __restrict__ src, unsigned char* __restrict__ dst, float* __restrict__ scale) {
  const int lane = TIDX & 63;
  for (int r = blockIdx.x * NWV + (TIDX >> 6); r < NEXP; r += gridDim.x * NWV) {
    float v[EPL];
#pragma unroll
    for (int k = 0; k < EW; ++k) { f32x4 x = *(const f32x4*)(src + (size_t)r * DM + lane * EPL + 4 * k); v[4 * k] = x.x; v[4 * k + 1] = x.y; v[4 * k + 2] = x.z; v[4 * k + 3] = x.w; }
    float mx = 0.f;
#pragma unroll
    for (int i = 0; i < EPL; ++i) mx = fmaxf(mx, fabsf(v[i]));
    mx = row16_max(mx);
    { float a = mx, b = mx; swap16(a, b); mx = fmaxf(mx, (threadIdx.x & 16) ? a : b); }
    mx = fmaxf(mx, partner32(mx));
    mx = fmaxf(mx, 1e-30f);
    const float inv = 6.0f / mx;
    unsigned w[U4W];
#pragma unroll
    for (int g = 0; g < U4W; ++g) {
      float a[8];
#pragma unroll
      for (int i = 0; i < 8; ++i) a[i] = v[8 * g + i] * inv;
      w[g] = pack_fp4x8(a);
    }
    if constexpr (U4W == 2) *(u32x2*)(dst + (size_t)r * DM + lane * EPL + EPL / 2) = u32x2{w[0], w[1]};
    else *(unsigned*)(dst + (size_t)r * DM + lane * EPL + EPL / 2) = w[0];
    if (lane == 0) scale[2 * r + 1] = mx * (1.0f / 6.0f);
  }
}
DEVFN void ph_prep(const Params& P, char* smem) {
  prep_wt(P.in[2], P.in[1], P.wt_in0, DM, EVEN_IN, smem);
  prep_wt(P.in[11], nullptr, P.wt_glu, AW, AW, smem);
  prep_wt(P.in[14], nullptr, P.wt_out0, DM, DM, smem);
  prep_wt(P.in[16], P.in[15], P.wt_q0, DM, QN, smem);
  prep_wt(P.in[22], P.in[21], P.wt_in1, DM, ODD_IN, smem);
  prep_wt(P.in[26], nullptr, P.wt_out1, DM, DM, smem);
  prep_wt(P.in[28], P.in[27], P.wt_q1, DM, QN, smem);
  const int kidx[4] = {17, 18, 29, 30};
#pragma unroll
  for (int i = 0; i < 4; ++i) cvt_bf16(P.in[kidx[i]], P.keys[i], (size_t)PH * NKEY * 128 / 4);
  prep_s5(P);
  for (int e = blockIdx.x * NT + TIDX; e < NH * 128 * 128; e += gridDim.x * NT) {
    const int t = (e >> 7) & 127, sidx = e & 127;
    P.wsb[e] = sidx <= t ? f2bf(P.in[24][e]) : (bf16_t)0;
  }
  rowstat(P.in[0], P.rinv, P.hb);
}

constexpr int GBK = 64, GLD = GBK + 8;
constexpr int GEMM_SMEM = 2 * 128 * GLD * 2;
template <class Epi>
DEVFN void gemm_tile_128(const bf16_t* __restrict__ A, int lda, const bf16_t* __restrict__ Wt, int K, int m0, int n0, char* sm, int tid, bool act, Epi& epi) {
  bf16_t* sA = (bf16_t*)sm;
  bf16_t* sB = sA + 128 * GLD;
  const int lane = tid & 63, wid = tid >> 6;
  const int wm = (wid >> 1) * 64, wn = (wid & 1) * 64;
  const int lr = tid >> 3, lc = (tid & 7) * 8;
  f32x16 acc[2][2];
#pragma unroll
  for (int i = 0; i < 2; ++i)
#pragma unroll
    for (int j = 0; j < 2; ++j)
#pragma unroll
      for (int r = 0; r < 16; ++r) acc[i][j][r] = 0.f;
  u32x4 ra[4], rb[4];
#pragma unroll
  for (int p = 0; p < 4; ++p) {
    ra[p] = *(const u32x4*)(A + (size_t)(m0 + lr + 32 * p) * lda + lc);
    rb[p] = *(const u32x4*)(Wt + (size_t)(n0 + lr + 32 * p) * K + lc);
  }
  for (int k0 = 0; k0 < K; k0 += GBK) {
    __syncthreads();
#pragma unroll
    for (int p = 0; p < 4; ++p) {
      *(u32x4*)(sA + (lr + 32 * p) * GLD + lc) = ra[p];
      *(u32x4*)(sB + (lr + 32 * p) * GLD + lc) = rb[p];
    }
    __syncthreads();
    {
      const int kn = (k0 + GBK < K) ? (k0 + GBK) : k0;
#pragma unroll
      for (int p = 0; p < 4; ++p) {
        ra[p] = *(const u32x4*)(A + (size_t)(m0 + lr + 32 * p) * lda + kn + lc);
        rb[p] = *(const u32x4*)(Wt + (size_t)(n0 + lr + 32 * p) * K + kn + lc);
      }
    }
#pragma unroll
    for (int kk = 0; kk < GBK; kk += 16) {
      bf16x8 fa[2], fb[2];
#pragma unroll
      for (int i = 0; i < 2; ++i) fa[i] = *(const bf16x8*)(sA + (wm + 32 * i + (lane & 31)) * GLD + kk + 8 * (lane >> 5));
#pragma unroll
      for (int j = 0; j < 2; ++j) fb[j] = *(const bf16x8*)(sB + (wn + 32 * j + (lane & 31)) * GLD + kk + 8 * (lane >> 5));
#pragma unroll
      for (int i = 0; i < 2; ++i)
#pragma unroll
        for (int j = 0; j < 2; ++j) acc[i][j] = mfma32(fa[i], fb[j], acc[i][j]);
    }
  }
  if (act) {
#pragma unroll
    for (int i = 0; i < 2; ++i)
#pragma unroll
      for (int j = 0; j < 2; ++j)
#pragma unroll
        for (int r = 0; r < 16; ++r) {
          int row = m0 + wm + 32 * i + (r & 3) + 8 * (r >> 2) + 4 * (lane >> 5);
          int col = n0 + wn + 32 * j + (lane & 31);
          epi(row, col, acc[i][j][r]);
        }
  }
}
struct EpiScaleBf16 {
  const float* rinv; bf16_t* out; int ldo;
  DEVFN void operator()(int row, int col, float v) { out[(size_t)row * ldo + col] = f2bf(rinv ? v * rinv[row] : v); }
};
struct EpiGlu {
  const bf16_t* ypre; const float* bias; bf16_t* out;
  DEVFN void operator()(int row, int col, float v) {
    float y = bf2f(ypre[(size_t)row * AW + col]);
    out[(size_t)row * DM + col] = f2bf(y * sigmoid_f(v + bias[col]));
  }
};
struct EpiResidual {
  const float* hin; float* hout; bf16_t* hb;
  DEVFN void operator()(int row, int col, float v) {
    size_t o = (size_t)row * DM + col;
    float h = hin[o] + v; hout[o] = h; hb[o] = f2bf(h);
  }
};
template <class Epi>
DEVFN void ph_gemm(const bf16_t* __restrict__ A, int lda, const bf16_t* __restrict__ Wt, int K, int N, Epi epi, char* smem) {
  const int sub = TIDX >> 8, stid = TIDX & 255;
  const int ntn = N / 128, ntiles = (T / 128) * ntn;
  const int stride = gridDim.x * 2;
  const int iters = (ntiles + stride - 1) / stride;
  for (int it = 0; it < iters; ++it) {
    int vb = (it * gridDim.x + blockIdx.x) * 2 + sub;
    const bool act = vb < ntiles;
    if (!act) vb = ntiles - 1;
    gemm_tile_128(A, lda, Wt, K, (vb / ntn) * 128, (vb % ntn) * 128, smem + sub * GEMM_SMEM, stid, act, epi);
  }
}


#ifndef HOST_EMU
namespace pg8 {
#define PG8_LAS __attribute__((address_space(3)))
constexpr int BM = 256, BK = 64, HALF = 128, HTB = HALF * BK * 2  , STAGE_BYTES = 8 * HTB, NXCD = 8, WGM = 8;
__host__ __device__ __forceinline__ int lds_byte(int r, int c) { const int st = (r >> 4) * 2 + (c >> 5), rr = r & 15, cc = c & 31, ob = rr * 64 + cc * 2; return st * 1024 + (ob ^ (((ob >> 9) & 1) << 5)); }
__host__ __device__ __forceinline__ void stage_rc(int b, int& R, int& C) { const int st = b / 1024, sb = b % 1024, swz = sb ^ (((sb >> 9) & 1) << 5); R = (st >> 1) * 16 + swz / 64; C = (st & 1) * 32 + (swz % 64) / 2; }
__host__ __device__ __forceinline__ int perm32(int rho) { const int n = rho >> 4, i = rho & 15; return 8 * (i >> 2) + 4 * n + (i & 3); }
struct Unit { int pm, pn; };
struct Gemm { const bf16_t* A; const bf16_t* Bt; int M, N, K; };
struct StaticOrder {
    int nM, nN, nwg, G, c;
    __host__ __device__ void init(int M, int N, int G_, int c_) { nM = M / BM; nN = N / BM; nwg = nM * nN; G = G_; c = c_; }
    __host__ __device__ bool next(int i, Unit& u) const {
        const long L = (long)i * G + c; if (L >= nwg) return false;
        int wgid = (int)L; { const int q = nwg / NXCD, r = nwg % NXCD, xcd = wgid % NXCD, off = wgid / NXCD; wgid = (xcd < r ? xcd * (q + 1) : r * (q + 1) + (xcd - r) * q) + off; }
        const int nig = WGM * nN, gid = wgid / nig, fm = gid * WGM, gsz = (nM - fm) < WGM ? (nM - fm) : WGM;
        u.pm = fm + ((wgid % nig) % gsz); u.pn = (wgid % nig) / gsz; return true;
    }
    __device__ __forceinline__ void a_ready(const Unit&) const {}
    __device__ __forceinline__ void done(const Unit&) const {}
};
__device__ __forceinline__ unsigned cvt_pk_bf16(float lo, float hi) { unsigned r; asm volatile("v_cvt_pk_bf16_f32 %0, %1, %2" : "=v"(r) : "v"(lo), "v"(hi)); return r; }
struct PEpiScaleBf16 {
    static constexpr bool PERM = true, AFTER_DRAIN = false;
    const float* rinv; bf16_t* out; int ldo;
    __device__ __forceinline__ void operator()(const f32x4 (&acc)[2][2][4][2], const Unit& u, int wr, int wc, int fr, int fq) const {
        const int row0 = u.pm * BM + wr * 64 + fr, col0 = u.pn * BM + wc * 32 + 8 * fq;
#pragma unroll
        for (int ai = 0; ai < 2; ++ai)
#pragma unroll
            for (int m = 0; m < 4; ++m) { const int row = row0 + ai * HALF + m * 16; const float sc = rinv ? rinv[row] : 1.0f; bf16_t* rowp = out + (size_t)row * ldo + col0;
#pragma unroll
                for (int bj = 0; bj < 2; ++bj) { const f32x4 v0 = acc[ai][bj][m][0] * sc, v1 = acc[ai][bj][m][1] * sc;
                    u32x4 w; w.x = cvt_pk_bf16(v0[0], v0[1]); w.y = cvt_pk_bf16(v0[2], v0[3]); w.z = cvt_pk_bf16(v1[0], v1[1]); w.w = cvt_pk_bf16(v1[2], v1[3]);
                    *(u32x4*)(rowp + bj * HALF) = w; } }
    }
};
struct PEpiGlu {
    static constexpr bool PERM = true, AFTER_DRAIN = false;
    const bf16_t* ypre; const float* bias; bf16_t* out;
    __device__ __forceinline__ void operator()(const f32x4 (&acc)[2][2][4][2], const Unit& u, int wr, int wc, int fr, int fq) const {
        const int row0 = u.pm * BM + wr * 64 + fr, col0 = u.pn * BM + wc * 32 + 8 * fq;
#pragma unroll
        for (int ai = 0; ai < 2; ++ai)
#pragma unroll
            for (int m = 0; m < 4; ++m) { const int row = row0 + ai * HALF + m * 16;
#pragma unroll
                for (int bj = 0; bj < 2; ++bj) { const int col = col0 + bj * HALF;
                    const f32x4 b0 = *(const f32x4*)(bias + col), b1 = *(const f32x4*)(bias + col + 4);
                    const u32x4 yp = *(const u32x4*)(ypre + (size_t)row * AW + col);
                    const f32x4 g0 = acc[ai][bj][m][0] + b0, g1 = acc[ai][bj][m][1] + b1;
                    u32x4 w;
                    w.x = cvt_pk_bf16(bflo(yp.x) * sigmoid_f(g0[0]), bfhi(yp.x) * sigmoid_f(g0[1])); w.y = cvt_pk_bf16(bflo(yp.y) * sigmoid_f(g0[2]), bfhi(yp.y) * sigmoid_f(g0[3]));
                    w.z = cvt_pk_bf16(bflo(yp.z) * sigmoid_f(g1[0]), bfhi(yp.z) * sigmoid_f(g1[1])); w.w = cvt_pk_bf16(bflo(yp.w) * sigmoid_f(g1[2]), bfhi(yp.w) * sigmoid_f(g1[3]));
                    *(u32x4*)(out + (size_t)row * DM + col) = w; } }
    }
};
struct PEpiResidual {
    static constexpr bool PERM = true, AFTER_DRAIN = false;
    const float* hin; float* hout; bf16_t* hb;
    __device__ __forceinline__ void operator()(const f32x4 (&acc)[2][2][4][2], const Unit& u, int wr, int wc, int fr, int fq) const {
        const int row0 = u.pm * BM + wr * 64 + fr, col0 = u.pn * BM + wc * 32 + 8 * fq;
#pragma unroll
        for (int ai = 0; ai < 2; ++ai)
#pragma unroll
            for (int m = 0; m < 4; ++m) { const int row = row0 + ai * HALF + m * 16;
#pragma unroll
                for (int bj = 0; bj < 2; ++bj) { const size_t o = (size_t)row * DM + col0 + bj * HALF;
                    const f32x4 v0 = *(const f32x4*)(hin + o) + acc[ai][bj][m][0], v1 = *(const f32x4*)(hin + o + 4) + acc[ai][bj][m][1];
                    *(f32x4*)(hout + o) = v0; *(f32x4*)(hout + o + 4) = v1;
                    u32x4 w; w.x = cvt_pk_bf16(v0[0], v0[1]); w.y = cvt_pk_bf16(v0[2], v0[3]); w.z = cvt_pk_bf16(v1[0], v1[1]); w.w = cvt_pk_bf16(v1[2], v1[3]);
                    *(u32x4*)(hb + o) = w; } }
    }
};
template <class Epi, class Sched>
__device__ __forceinline__ void gemm_phase(PG8_LAS unsigned char* lds, const Gemm g, const Sched& S, const Epi& E) {
    const int tid = opaque_tid(), wid = __builtin_amdgcn_readfirstlane(tid >> 6), lane = tid & 63, wr = wid >> 2, wc = wid & 3, fr = lane & 15, fq = lane >> 4;
    const int K = g.K, nt = K / BK;
    unsigned voffA[2], voffB[2];
#pragma unroll
    for (int i = 0; i < 2; ++i) { int R, C; stage_rc(tid * 16 + i * 8192, R, C); const int Rb = Epi::PERM ? ((R & ~31) + perm32(R & 31)) : R;
        voffA[i] = (unsigned)(R * K + C) * 2u; voffB[i] = (unsigned)(Rb * K + C) * 2u; }
    const size_t kstep = (size_t)(BK * 2);
    const size_t hstep = (size_t)HALF * K * 2;
    const size_t tstep = 2 * hstep;
    const unsigned ldsw = (unsigned)wid * 1024u;
    const int aoff = lds_byte(wr * 64 + fr, fq * 8), boff = lds_byte(wc * 32 + fr, fq * 8);
#define PG8_SA(b, h) (((b) * 2 + (h)) * HTB)
#define PG8_SB(b, h) ((4 + (b) * 2 + (h)) * HTB)
#define PG8_STAGE(bufoff, gbase, voff) do { _Pragma("unroll") for (int _i = 0; _i < 2; ++_i) \
        __builtin_amdgcn_global_load_lds((const unsigned*)((const char*)(gbase) + (voff)[_i]), (PG8_LAS unsigned*)(lds + (bufoff) + ldsw + _i * 8192), 16, 0, 0); } while (0)
#define PG8_LDA(dst, b, h) do { _Pragma("unroll") for (int m = 0; m < 4; ++m) _Pragma("unroll") for (int k = 0; k < 2; ++k) dst[m][k] = *(const PG8_LAS bf16x8*)(lds + PG8_SA(b, h) + aoff + m * 2048 + k * 1024); } while (0)
#define PG8_LDB(dst, b, h) do { _Pragma("unroll") for (int n = 0; n < 2; ++n) _Pragma("unroll") for (int k = 0; k < 2; ++k) dst[n][k] = *(const PG8_LAS bf16x8*)(lds + PG8_SB(b, h) + boff + n * 2048 + k * 1024); } while (0)
#define PG8_MMA(ai, bj, At, Bt) do { __builtin_amdgcn_s_setprio(1); _Pragma("unroll") for (int m = 0; m < 4; ++m) _Pragma("unroll") for (int n = 0; n < 2; ++n) _Pragma("unroll") for (int k = 0; k < 2; ++k) \
        acc[ai][bj][m][n] = __builtin_amdgcn_mfma_f32_16x16x32_bf16(Bt[n][k], At[m][k], acc[ai][bj][m][n], 0, 0, 0); __builtin_amdgcn_s_setprio(0); } while (0)
#define PG8_WAIT_V(n) asm volatile("s_waitcnt vmcnt(" #n ")" ::: "memory")
#define PG8_WAIT_L(n) asm volatile("s_waitcnt lgkmcnt(" #n ")" ::: "memory")
#define PG8_BAR __builtin_amdgcn_s_barrier()
#define PG8_SCHED __builtin_amdgcn_sched_barrier(0)
    Unit cur, nxt; int ui = 0;
    if (!S.next(0, cur)) return;
    f32x4 acc[2][2][4][2];
#pragma unroll
    for (int a = 0; a < 2; ++a)
#pragma unroll
        for (int b = 0; b < 2; ++b)
#pragma unroll
            for (int m = 0; m < 4; ++m)
#pragma unroll
                for (int n = 0; n < 2; ++n) acc[a][b][m][n] = (f32x4){0.f, 0.f, 0.f, 0.f};
    bf16x8 At[4][2], B0[2][2], B1[2][2];
    const char* cA = (const char*)g.A + (size_t)cur.pm * tstep; const char* cB = (const char*)g.Bt + (size_t)cur.pn * tstep;
    S.a_ready(cur);
    PG8_STAGE(PG8_SB(0, 0), cB, voffB); PG8_STAGE(PG8_SA(0, 0), cA, voffA); PG8_STAGE(PG8_SB(0, 1), cB + hstep, voffB); PG8_STAGE(PG8_SA(0, 1), cA + hstep, voffA);
    if (wr == 1) PG8_BAR;
    PG8_WAIT_V(4); PG8_BAR;
    PG8_STAGE(PG8_SB(1, 0), cB + kstep, voffB); PG8_STAGE(PG8_SA(1, 0), cA + kstep, voffA); PG8_STAGE(PG8_SB(1, 1), cB + hstep + kstep, voffB);
    PG8_WAIT_V(6); PG8_BAR;
    for (;;) {
        const bool has_next = S.next(ui + 1, nxt);
        const char* nA = has_next ? (const char*)g.A + (size_t)nxt.pm * tstep : cA; const char* nB = has_next ? (const char*)g.Bt + (size_t)nxt.pn * tstep : cB;
        for (int t = 0; t < nt; t += 2) {
            const bool last = (t == nt - 2);
            const char* a1 = cA + (size_t)(t + 1) * kstep;
            const char* a2 = last ? nA : cA + (size_t)(t + 2) * kstep; const char* b2 = last ? nB : cB + (size_t)(t + 2) * kstep;
            const char* a3 = a2 + kstep; const char* b3 = b2 + kstep;
            if (last && has_next) S.a_ready(nxt);
            PG8_LDB(B0, 0, 0); PG8_SCHED; PG8_LDA(At, 0, 0); PG8_STAGE(PG8_SA(1, 1), a1 + hstep, voffA);
            PG8_WAIT_L(8); PG8_BAR; PG8_WAIT_L(0); PG8_MMA(0, 0, At, B0); PG8_BAR; PG8_SCHED;
            PG8_LDB(B1, 0, 1); PG8_STAGE(PG8_SB(0, 0), b2, voffB);
            PG8_BAR; PG8_WAIT_L(0); PG8_MMA(0, 1, At, B1); PG8_BAR;
            PG8_LDA(At, 0, 1); PG8_STAGE(PG8_SA(0, 0), a2, voffA);
            PG8_BAR; PG8_WAIT_L(0); PG8_MMA(1, 0, At, B0); PG8_BAR; PG8_SCHED;
            PG8_STAGE(PG8_SB(0, 1), b2 + hstep, voffB);
            PG8_WAIT_V(6); PG8_BAR; PG8_MMA(1, 1, At, B1); PG8_BAR;
            PG8_LDB(B0, 1, 0); PG8_SCHED; PG8_LDA(At, 1, 0); PG8_STAGE(PG8_SA(0, 1), a2 + hstep, voffA);
            PG8_WAIT_L(8); PG8_BAR; PG8_WAIT_L(0); PG8_MMA(0, 0, At, B0); PG8_BAR; PG8_SCHED;
            PG8_LDB(B1, 1, 1); PG8_STAGE(PG8_SB(1, 0), b3, voffB);
            PG8_BAR; PG8_WAIT_L(0); PG8_MMA(0, 1, At, B1); PG8_BAR;
            PG8_LDA(At, 1, 1); PG8_STAGE(PG8_SA(1, 0), a3, voffA);
            PG8_BAR; PG8_WAIT_L(0); PG8_MMA(1, 0, At, B0); PG8_BAR; PG8_SCHED;
            PG8_STAGE(PG8_SB(1, 1), b3 + hstep, voffB);
            PG8_WAIT_V(6); PG8_BAR; PG8_MMA(1, 1, At, B1); PG8_BAR;
        }
        if constexpr (!Epi::AFTER_DRAIN) { E(acc, cur, wr, wc, fr, fq); S.done(cur); }
        if (!has_next) break;
#pragma unroll
        for (int a = 0; a < 2; ++a)
#pragma unroll
            for (int b = 0; b < 2; ++b)
#pragma unroll
                for (int m = 0; m < 4; ++m)
#pragma unroll
                    for (int n = 0; n < 2; ++n) acc[a][b][m][n] = (f32x4){0.f, 0.f, 0.f, 0.f};
        cur = nxt; cA = nA; cB = nB; ++ui;
    }
    PG8_WAIT_V(0);
    if (wr == 0) PG8_BAR;
    PG8_BAR;
    if constexpr (Epi::AFTER_DRAIN) { E.fused(acc, cur, wr, wc, fr, fq, lds, wid, lane); S.done(cur); }
#undef PG8_SA
#undef PG8_SB
#undef PG8_STAGE
#undef PG8_LDA
#undef PG8_LDB
#undef PG8_MMA
#undef PG8_WAIT_V
#undef PG8_WAIT_L
#undef PG8_BAR
#undef PG8_SCHED
}

}
template <class PEpi>
DEVFN void ph_gemm8(const bf16_t* A, const bf16_t* Wt, int K, int N, const PEpi& E, char* smem) {
  pg8::StaticOrder S; S.init(T, N, (int)gridDim.x, (int)blockIdx.x);
  pg8::gemm_phase<PEpi, pg8::StaticOrder>((PG8_LAS unsigned char*)smem, pg8::Gemm{A, Wt, T, N, K}, S, E);
}
#define GEMM_SCALE(A, Wt, K, N, rinvp, outp) ph_gemm8(A, Wt, K, N, pg8::PEpiScaleBf16{rinvp, outp, N}, smem)
#define GEMM_GLU(A, Wt, K, N, yprep, biasp, outp) ph_gemm8(A, Wt, K, N, pg8::PEpiGlu{yprep, biasp, outp}, smem)
#define GEMM_RES(A, Wt, K, N, hinp, houtp, hbp) ph_gemm8(A, Wt, K, N, pg8::PEpiResidual{hinp, houtp, hbp}, smem)
#else
#define GEMM_SCALE(A, Wt, K, N, rinvp, outp) ph_gemm(A, K, Wt, K, N, EpiScaleBf16{rinvp, outp, N}, smem)
#define GEMM_GLU(A, Wt, K, N, yprep, biasp, outp) ph_gemm(A, K, Wt, K, N, EpiGlu{yprep, biasp, outp}, smem)
#define GEMM_RES(A, Wt, K, N, hinp, houtp, hbp) ph_gemm(A, K, Wt, K, N, EpiResidual{hinp, houtp, hbp}, smem)
#endif

DEVFN void s5_bu(const bf16_t* __restrict__ pb, const S5Tab& tb, int tok0, int g, int lane, int pp, f32x16 (&acc)[2][2]) {
  const int half = lane >> 5, i = lane & 31;
  const int tau = 16 * ((i >> 2) & 1) + 4 * (i >> 3) + (i & 3);
  bf16x8 au[2], bb[2];
#pragma unroll
  for (int mt = 0; mt < 2; ++mt) au[mt] = *(const bf16x8*)(pb + (size_t)(tok0 + mt * 32 + tau) * EVEN_IN + g * 16 + 8 * half);
#pragma unroll
  for (int part = 0; part < 2; ++part) bb[part] = *(const bf16x8*)(tb.bbT + ((size_t)g * 128 + (2 * part + pp) * 32 + i) * 16 + 8 * half);
#pragma unroll
  for (int mt = 0; mt < 2; ++mt)
#pragma unroll
    for (int part = 0; part < 2; ++part) {
#pragma unroll
      for (int r = 0; r < 16; ++r) acc[mt][part][r] = 0.f;
      acc[mt][part] = mfma32(au[mt], bb[part], acc[mt][part]);
    }
}
DEVFN void s5_local_scan(f32x16 (&acc)[2][2], float ar, float ai) {
#pragma unroll
  for (int mt = 0; mt < 2; ++mt)
#pragma unroll
    for (int k = 1; k < 16; ++k) {
      const float pr = acc[mt][0][k - 1], pi = acc[mt][1][k - 1];
      acc[mt][0][k] += ar * pr - ai * pi;
      acc[mt][1][k] += ar * pi + ai * pr;
    }
}
DEVFN void s5_carries(const f32x16 (&acc)[2][2], int half, float a16r, float a16i, float c0r, float c0i, float (&csr)[5], float (&csi)[5]) {
  float er[4], ei[4];
#pragma unroll
  for (int mt = 0; mt < 2; ++mt) {
    const float ownr = acc[mt][0][15], owni = acc[mt][1][15];
    const float parr = partner32(ownr), pari = partner32(owni);
    er[2 * mt] = half ? parr : ownr; ei[2 * mt] = half ? pari : owni;
    er[2 * mt + 1] = half ? ownr : parr; ei[2 * mt + 1] = half ? owni : pari;
  }
  csr[0] = c0r; csi[0] = c0i;
#pragma unroll
  for (int j = 0; j < 4; ++j) { csr[j + 1] = a16r * csr[j] - a16i * csi[j] + er[j]; csi[j + 1] = a16r * csi[j] + a16i * csr[j] + ei[j]; }
}
DEVFN void ph_s5_pass1(const Params& P) {
  const int tid = TIDX, lane = tid & 63, wv = tid >> 6, half = lane >> 5;
  const S5Tab& tb = P.tb;
  for (int item = blockIdx.x * NWV + wv; item < NB * NCH * NG; item += gridDim.x * NWV) {
    const int g = item % NG, ch = (item / NG) % NCH, b = item / (NG * NCH);
    float* dst = P.S + ((size_t)(b * NCH + ch) * NG + g) * 128;
#pragma unroll
    for (int pp = 0; pp < 2; ++pp) {
      const int p = pp * 32 + (lane & 31);
      f32x16 acc[2][2];
      s5_bu(P.pb, tb, b * SEQ + ch * SQ, g, lane, pp, acc);
      s5_local_scan(acc, tb.ar[g * NST + p], tb.ai[g * NST + p]);
      float csr[5], csi[5];
      s5_carries(acc, half, tb.a16r[g * NST + p], tb.a16i[g * NST + p], 0.f, 0.f, csr, csi);
      if (half == 0) { dst[p] = csr[4]; dst[64 + p] = csi[4]; }
    }
  }
}
DEVFN void ph_s5_pass2(const Params& P) {
  for (int gid = blockIdx.x * NT + TIDX; gid < NB * NG * NST; gid += gridDim.x * NT) {
  const int p = gid % NST, g = (gid / NST) % NG, b = gid / (NST * NG), gp = g * NST + p;
  const float qr = P.tb.aqr[gp], qi = P.tb.aqi[gp];
  const float* __restrict__ S = P.S; float* __restrict__ S2 = P.S2;
  float hr = 0.f, hi = 0.f;
  for (int c0 = 0; c0 < NCH; c0 += 8) {
    float sr[8], si[8];
#pragma unroll
    for (int j = 0; j < 8; ++j) { const float* d = S + ((size_t)(b * NCH + c0 + j) * NG + g) * 128; sr[j] = d[p]; si[j] = d[64 + p]; }
#pragma unroll
    for (int j = 0; j < 8; ++j) {
      float* d = S2 + ((size_t)(b * NCH + c0 + j) * NG + g) * 128;
      d[p] = hr; d[64 + p] = hi;
      float nr = qr * hr - qi * hi + sr[j], ni = qr * hi + qi * hr + si[j];
      hr = nr; hi = ni;
    }
  }
  }
}
constexpr int HLD = 128 + 8;
DEVFN void ph_s5_pass3(const Params& P, char* smem) {
  const int tid = TIDX, lane = tid & 63, wv = tid >> 6, half = lane >> 5, l31 = lane & 31;
  bf16_t* Hl = (bf16_t*)(smem + wv * (64 * HLD * 2));
  const S5Tab& tb = P.tb;
  for (int item = blockIdx.x * NWV + wv; item < NB * NCH * NG; item += gridDim.x * NWV) {
    const int g = item % NG, ch = (item / NG) % NCH, b = item / (NG * NCH);
    const int tok0 = b * SEQ + ch * SQ;
    const float* src = P.S2 + ((size_t)(b * NCH + ch) * NG + g) * 128;
    WAVE_SYNC();
#pragma unroll
    for (int pp = 0; pp < 2; ++pp) {
      const int p = pp * 32 + l31;
      const float ar = tb.ar[g * NST + p], ai = tb.ai[g * NST + p];
      f32x16 acc[2][2];
      s5_bu(P.pb, tb, tok0, g, lane, pp, acc);
      s5_local_scan(acc, ar, ai);
      float csr[5], csi[5];
      s5_carries(acc, half, tb.a16r[g * NST + p], tb.a16i[g * NST + p], src[p], src[64 + p], csr, csi);
#pragma unroll
      for (int mt = 0; mt < 2; ++mt) {
        const float cr = half ? csr[2 * mt + 1] : csr[2 * mt], ci = half ? csi[2 * mt + 1] : csi[2 * mt];
        float pr = ar, pi = ai;
#pragma unroll
        for (int k = 0; k < 16; ++k) {
          const float hr = acc[mt][0][k] + pr * cr - pi * ci, hi = acc[mt][1][k] + pr * ci + pi * cr;
          const float nr = pr * ar - pi * ai, ni = pr * ai + pi * ar;
          pr = nr; pi = ni;
          *(unsigned*)(Hl + (mt * 32 + 16 * half + k) * HLD + 4 * l31 + 2 * pp) = pack2(hr, hi);
        }
      }
    }
    WAVE_SYNC();
    f32x16 y[2];
#pragma unroll
    for (int mt = 0; mt < 2; ++mt)
#pragma unroll
      for (int r = 0; r < 16; ++r) y[mt][r] = 0.f;
    const bf16x8 zero8 = {0, 0, 0, 0, 0, 0, 0, 0};
#pragma unroll
    for (int ks = 0; ks < 9; ++ks) {
      const bf16x8 fb = l31 < 16 ? *(const bf16x8*)(tb.cmP + ((size_t)g * 16 + l31) * CMK + ks * 16 + 8 * half) : zero8;
#pragma unroll
      for (int mt = 0; mt < 2; ++mt) {
        const bf16x8 fa = ks < 8 ? *(const bf16x8*)(Hl + (mt * 32 + l31) * HLD + ks * 16 + 8 * half)
                                 : *(const bf16x8*)(P.pb + (size_t)(tok0 + mt * 32 + l31) * EVEN_IN + g * 16 + 8 * half);
        y[mt] = mfma32(fa, fb, y[mt]);
      }
    }
    if (l31 < 16) {
#pragma unroll
      for (int mt = 0; mt < 2; ++mt)
#pragma unroll
        for (int r = 0; r < 16; ++r) {
          const int t = mt * 32 + (r & 3) + 8 * (r >> 2) + 4 * half;
          P.ya[(size_t)(tok0 + t) * AW + g * 16 + l31] = f2bf(gelu_f(y[mt][r]));
        }
    }
  }
}

DEVFN void ph_conv(const Params& P) {
  const bf16_t* __restrict__ pb = P.pb; const float* __restrict__ cw = P.in[13]; bf16_t* __restrict__ cb = P.cb;
  const int per_row = AW / 8;
  for (int e = blockIdx.x * NT + TIDX; e < T * per_row; e += gridDim.x * NT) {
    const int t = e / per_row, c0 = (e % per_row) * 8;
    const int l = t % SEQ;
    const bf16_t* row = pb + (size_t)t * EVEN_IN;
    float acc[8];
#pragma unroll
    for (int j = 0; j < 8; ++j) acc[j] = 0.f;
#pragma unroll
    for (int d = 0; d < 3; ++d) {
      if (l - 2 + d < 0) continue;
      const bf16_t* r2 = row - (size_t)(2 - d) * EVEN_IN;
      u32x4 cg = *(const u32x4*)(r2 + 2 * AW + c0), xi = *(const u32x4*)(r2 + 3 * AW + c0);
      const unsigned cgs[4] = {cg.x, cg.y, cg.z, cg.w}, xis[4] = {xi.x, xi.y, xi.z, xi.w};
#pragma unroll
      for (int j = 0; j < 4; ++j) {
        acc[2 * j] += cw[d * AW + c0 + 2 * j] * bflo(cgs[j]) * bflo(xis[j]);
        acc[2 * j + 1] += cw[d * AW + c0 + 2 * j + 1] * bfhi(cgs[j]) * bfhi(xis[j]);
      }
    }
    u32x4 bg = *(const u32x4*)(row + AW + c0);
    const unsigned bgs[4] = {bg.x, bg.y, bg.z, bg.w};
    unsigned w[4];
#pragma unroll
    for (int j = 0; j < 4; ++j) w[j] = pack2(bflo(bgs[j]) * acc[2 * j], bfhi(bgs[j]) * acc[2 * j + 1]);
    *(u32x4*)(cb + (size_t)t * DM + AW + c0) = u32x4{w[0], w[1], w[2], w[3]};
  }
}

DEVFN int f2key(float f) { const int b = __builtin_bit_cast(int, f); return b ^ ((b >> 31) & 0x7fffffff); }
DEVFN float key2f(int k) { return __builtin_bit_cast(float, k ^ ((k >> 31) & 0x7fffffff)); }
DEVFN int imax(int a, int b) { return a > b ? a : b; }
DEVFN int imin(int a, int b) { return a < b ? a : b; }
DEVFN void cmpx(int& a, int& b) { const int hi = imax(a, b), lo = imin(a, b); a = hi; b = lo; }
DEVFN void merge_partner(int (&v)[16]) {
  int pv[16];
#pragma unroll
  for (int k = 0; k < 16; ++k) pv[k] = __shfl_xor(v[k], 32);
#pragma unroll
  for (int k = 0; k < 16; ++k) v[k] = imax(v[k], pv[15 - k]);
#pragma unroll
  for (int st = 8; st >= 1; st >>= 1)
#pragma unroll
    for (int k = 0; k < 16; ++k)
      if ((k & st) == 0) cmpx(v[k], v[k + st]);
}
DEVFN void sort16_desc(int (&v)[16]) {
#pragma unroll
  for (int k = 2; k <= 16; k <<= 1)
#pragma unroll
    for (int j = k >> 1; j >= 1; j >>= 1)
#pragma unroll
      for (int i = 0; i < 16; ++i) {
        const int l = i ^ j;
        if (l > i) { if ((i & k) == 0) cmpx(v[i], v[l]); else cmpx(v[l], v[i]); }
      }
}
DEVFN void merge16_desc(int (&a)[16], const int (&b)[16]) {
#pragma unroll
  for (int k = 0; k < 16; ++k) a[k] = imax(a[k], b[15 - k]);
#pragma unroll
  for (int st = 8; st >= 1; st >>= 1)
#pragma unroll
    for (int k = 0; k < 16; ++k)
      if ((k & st) == 0) cmpx(a[k], a[k + st]);
}
constexpr int KLD = 128 + 8;
DEVFN void topk_part(const bf16_t* __restrict__ qp, const bf16_t* sk, int lane, int half, int (&kv)[16]) {
  f32x16 acc[4];
#pragma unroll
  for (int mi = 0; mi < 4; ++mi)
#pragma unroll
    for (int r = 0; r < 16; ++r) acc[mi][r] = 0.f;
#pragma unroll
  for (int s = 0; s < 8; ++s) {
    const bf16x8 fb = *(const bf16x8*)(qp + s * 16);
#pragma unroll
    for (int mi = 0; mi < 4; ++mi) {
      const bf16x8 fa = *(const bf16x8*)(sk + (mi * 32 + (lane & 31)) * KLD + s * 16 + 8 * half);
      acc[mi] = mfma32(fa, fb, acc[mi]);
    }
  }
  const int hb = 4 * half;
  int g[4][16];
#pragma unroll
  for (int mi = 0; mi < 4; ++mi) {
#pragma unroll
    for (int r = 0; r < 16; ++r) g[mi][r] = (f2key(acc[mi][r]) & ~127) | (127 - (mi * 32 + (r & 3) + 8 * (r >> 2)) - hb);
    sort16_desc(g[mi]);
  }
  merge16_desc(g[0], g[1]); merge16_desc(g[2], g[3]); merge16_desc(g[0], g[2]);
#pragma unroll
  for (int k = 0; k < 16; ++k) kv[k] = g[0][k];
  merge_partner(kv);
}
constexpr int pair_ab(int idx) { int n = 0; for (int a = 0; a < 16; ++a) for (int b = 0; b < 16; ++b) if ((a + 1) * (b + 1) <= 16) { if (n == idx) return a * 16 + b; ++n; } return 0; }
template <int I> DEVFN void cand_step(const float (&v1f)[16], const float (&v2f)[16], int half, int (&ck)[16]) {
  constexpr int p0 = pair_ab(2 * I), p1 = pair_ab(2 * I + 1);
  const float s0 = v1f[p0 >> 4] + v2f[p0 & 15], s1 = v1f[p1 >> 4] + v2f[p1 & 15];
  int x = (f2key(half ? s1 : s0) & ~255) | (half ? (255 - p1) : (255 - p0));
#pragma unroll
  for (int k = 0; k < 16; ++k) if (k < I) cmpx(ck[k], x);
  if (I < 16) ck[I < 16 ? I : 0] = x;
}
template <int... I> DEVFN void cand_all(const float (&v1f)[16], const float (&v2f)[16], int half, int (&ck)[16], std::integer_sequence<int, I...>) { (cand_step<I>(v1f, v2f, half, ck), ...); }
DEVFN void ph_topk(const bf16_t* __restrict__ q, const bf16_t* __restrict__ k1, const bf16_t* __restrict__ k2,
                   int* __restrict__ idx_out, float* __restrict__ gate_out, char* smem) {
  bf16_t* sk = (bf16_t*)smem;
  const int tid = TIDX, lane = tid & 63, wv = tid >> 6, half = lane >> 5;
  unsigned char* lut = (unsigned char*)(smem + 2 * 128 * KLD * 2) + (wv * 64 + lane) * 32;
  constexpr int NITEM = (T / 256) * PH;
  const int iters = (NITEM + gridDim.x - 1) / gridDim.x;
  int h_lds = -1;
  for (int it = 0; it < iters; ++it) {
    const int item = it * gridDim.x + blockIdx.x;
    const bool act = item < NITEM;
    const int h = item % PH, tile = item / PH;
    if (h != h_lds) {
      __syncthreads();
      if (act)
        for (int e = tid; e < 2 * 128 * 16; e += NT) {
          const int part = e >> 11, row = (e >> 4) & 127, c8 = (e & 15) * 8;
          *(u32x4*)(sk + (part * 128 + row) * KLD + c8) = *(const u32x4*)((part ? k2 : k1) + ((size_t)h * NKEY + row) * 128 + c8);
        }
      __syncthreads();
      h_lds = act ? h : -1;
    }
    if (!act) continue;
    const int tok = tile * 256 + wv * 32 + (lane & 31);
    int kv1[16], kv2[16];
    topk_part(q + (size_t)tok * QN + h * 256 + 8 * half, sk, lane, half, kv1);
    topk_part(q + (size_t)tok * QN + h * 256 + 128 + 8 * half, sk + 128 * KLD, lane, half, kv2);
    float v1f[16], v2f[16];
#pragma unroll
    for (int k = 0; k < 16; ++k) {
      v1f[k] = key2f(kv1[k] & ~127); v2f[k] = key2f(kv2[k] & ~127);
      lut[k] = (unsigned char)(127 - (kv1[k] & 127)); lut[16 + k] = (unsigned char)(127 - (kv2[k] & 127));
    }
    int ck[16];
    cand_all(v1f, v2f, half, ck, std::make_integer_sequence<int, 25>{});
    merge_partner(ck);
    unsigned oi[8]; float og[8];
#pragma unroll
    for (int j = 0; j < 8; ++j) {
      int k0 = ck[j], k1 = ck[8 + j];
      OPAQUE(k0); OPAQUE(k1);
      const int kk = half ? k1 : k0;
      const int pos = 255 - (kk & 255);
      oi[j] = (unsigned)lut[pos >> 4] * NKEY + (unsigned)lut[16 + (pos & 15)];
      og[j] = key2f(kk & ~255);
    }
    const size_t o = (size_t)tok * NSEL + h * TOPK + 8 * half;
    *(u32x4*)(idx_out + o) = u32x4{oi[0], oi[1], oi[2], oi[3]}; *(u32x4*)(idx_out + o + 4) = u32x4{oi[4], oi[5], oi[6], oi[7]};
    *(f32x4*)(gate_out + o) = f32x4{og[0], og[1], og[2], og[3]}; *(f32x4*)(gate_out + o + 4) = f32x4{og[4], og[5], og[6], og[7]};
  }
}

#ifdef HOST_EMU
struct XcdBarrier { int dummy; };
#endif
#ifndef HOST_EMU
#define XB_TMO      128
#define XB_XCNT(j)  (256  + 64 * (j))
#define XB_XSUB(j)  (1280 + 64 * (j))
#define XB_XGEN(j)  (2304 + 64 * (j))
#define XB_TOP      3328
#define XB_TOPGEN   3392
#define XB_PACE(j)  (3456 + 64 * (j))
#define XCD_BAR_WORDS 4480
#define XB_SPIN_CAP (1u << 20)
#define LAS __attribute__((address_space(3)))
DEVFN unsigned xb_ld(unsigned* p)              { return __hip_atomic_load(p, __ATOMIC_RELAXED, __HIP_MEMORY_SCOPE_AGENT); }
DEVFN unsigned xb_add(unsigned* p, unsigned v) { return __hip_atomic_fetch_add(p, v, __ATOMIC_RELAXED, __HIP_MEMORY_SCOPE_AGENT); }
DEVFN unsigned xb_xcc_id() { return (unsigned)__builtin_amdgcn_s_getreg((3 << 11) | 20) & 0xFu; }
#define XB_SPIN(cond, bar) do { unsigned _sp = 0; while (cond) { __builtin_amdgcn_s_sleep(1); \
    if ((++_sp & 255u) == 0u) { if (xb_ld(&(bar)[XB_TMO])) break; if (_sp > XB_SPIN_CAP) { atomicAdd(&(bar)[XB_TMO], 1u); break; } } } } while (0)
struct XcdBarrier { unsigned* bar; unsigned x; volatile LAS unsigned* st; };
DEVFN XcdBarrier xcd_barrier_post(unsigned* bar, volatile LAS unsigned* st) {
  XcdBarrier b; b.bar = bar; b.x = xb_xcc_id(); b.st = st;
  if (threadIdx.x == 0) (void)xb_add(&bar[XB_XCNT(b.x)], 1u);
  return b;
}
DEVFN void xcd_barrier_complete(unsigned* bar, unsigned x, unsigned& nloc, unsigned& nx) {
  const unsigned G = gridDim.x * gridDim.y * gridDim.z;
  unsigned sum, cnt, mine, sp = 0u;
  for (;;) {
    sum = 0u; cnt = 0u; mine = 0u;
#pragma unroll
    for (unsigned j = 0; j < 16; ++j) { const unsigned c = xb_ld(&bar[XB_XCNT(j)]); sum += c; cnt += (c > 0u) ? 1u : 0u; mine = (j == x) ? c : mine; }
    if (sum == G) break;
    __builtin_amdgcn_s_sleep(1);
    if ((++sp & 255u) == 0u) { if (xb_ld(&bar[XB_TMO])) break; if (sp > XB_SPIN_CAP) { atomicAdd(&bar[XB_TMO], 1u); break; } }
  }
  nloc = mine > 0u ? mine : 1u; nx = cnt > 0u ? cnt : 1u;
}
DEVFN void xcd_barrier(const XcdBarrier& b) {
  asm volatile("s_waitcnt vmcnt(0)" ::: "memory");
  __syncthreads();
  if (threadIdx.x == 0) {
    unsigned* bar = b.bar;
    __builtin_amdgcn_s_waitcnt(0);
    unsigned nloc = b.st[0], nx = b.st[1];
    if (nloc == 0u) { xcd_barrier_complete(bar, b.x, nloc, nx); b.st[0] = nloc; b.st[1] = nx; }
    const unsigned old = xb_add(&bar[XB_XSUB(b.x)], 1u);
    const unsigned gen = old / nloc;
    if (old + 1u == (gen + 1u) * nloc) {
      __builtin_amdgcn_fence(__ATOMIC_RELEASE, "agent");
      asm volatile("s_waitcnt vmcnt(0)" ::: "memory");
      const unsigned og = xb_add(&bar[XB_TOP], 1u);
      const unsigned tg = og / nx;
      if (og + 1u == (tg + 1u) * nx) xb_add(&bar[XB_TOPGEN], 1u);
      else XB_SPIN(xb_ld(&bar[XB_TOPGEN]) == tg, bar);
      __builtin_amdgcn_fence(__ATOMIC_ACQUIRE, "agent");
      xb_add(&bar[XB_XGEN(b.x)], 1u);
      asm volatile("s_waitcnt vmcnt(0)" ::: "memory");
    } else {
      XB_SPIN(xb_ld(&bar[XB_XGEN(b.x)]) == gen, bar);
      __builtin_amdgcn_fence(__ATOMIC_ACQUIRE, "agent");
      asm volatile("s_waitcnt vmcnt(0)" ::: "memory");
    }
  }
  __syncthreads();
}
#define XSYNC() xcd_barrier(xb)
constexpr unsigned PACE_LAG = 1;
struct XcdPace { unsigned* ctr; unsigned nloc; unsigned step; };
DEVFN unsigned sload_glc(const unsigned* p) {
  unsigned v;
  const unsigned long long a = (unsigned long long)p;
  p = (const unsigned*)(((unsigned long long)(unsigned)__builtin_amdgcn_readfirstlane((int)(a >> 32)) << 32) | (unsigned)__builtin_amdgcn_readfirstlane((int)a));
  asm volatile("s_load_dword %0, %1, 0x0 glc\n\ts_waitcnt lgkmcnt(0)" : "=s"(v) : "s"(p) : "memory");
  return v;
}
DEVFN XcdPace xcd_pace_init(const XcdBarrier& b, int which) {
  XcdPace pc; pc.ctr = b.bar + XB_PACE(b.x) + 32 * which; pc.nloc = (unsigned)__builtin_amdgcn_readfirstlane((int)b.st[0]); pc.step = 0u;
  return pc;
}
#ifndef CFG_XPACE
#define CFG_XPACE 0
#endif
DEVFN void xcd_pace(XcdPace& pc) {
  ++pc.step;
  if (CFG_XPACE && __builtin_amdgcn_readfirstlane((int)(threadIdx.x >> 6)) == 0) {
    if (threadIdx.x == 0) (void)xb_add(pc.ctr, 1u);
    if (pc.step > PACE_LAG) {
      const unsigned need = pc.nloc * (pc.step - PACE_LAG);
      if ((int)(sload_glc(pc.ctr) - need) < 0) {
        unsigned sp = 0u;
        while ((int)(xb_ld(pc.ctr) - need) < 0) { __builtin_amdgcn_s_sleep(1); if (++sp > (1u << 16)) break; }
      }
    }
  }
  __syncthreads();
}
#else
#define XCD_BAR_WORDS 3456
#define XSYNC() emu_grid_sync()
struct XcdPace { int step; };
DEVFN XcdPace xcd_pace_init(const XcdBarrier&, int) { return XcdPace{0}; }
DEVFN void xcd_pace(XcdPace& pc) { ++pc.step; __syncthreads(); }
#endif


static_assert(EW == 4 || EW == 2, "row vector width");
constexpr int IDXR = (NSEL + 63) / 64;
#ifndef CFG_GPACE
#define CFG_GPACE 0
#endif
#ifndef CFG_GSH
#define CFG_GSH 11
#endif
#ifndef CFG_UPM
#define CFG_UPM 12
#endif
#ifndef CFG_VPM
#define CFG_VPM 4
#endif
constexpr int GSH = CFG_GSH;
constexpr int UPM = CFG_UPM;
constexpr int VPM = CFG_VPM;
constexpr int RB = 8;
struct RowBatch { unsigned w[RB][EW]; };
DEVFN void load_row(const unsigned char* __restrict__ p, int lane, unsigned (&w)[EW]) {
  if constexpr (EW == 4) { u32x4 x = *(const u32x4*)(p + lane * EPL); w[0] = x.x; w[1] = x.y; w[2] = x.z; w[3] = x.w; }
  else { u32x2 x = *(const u32x2*)(p + lane * EPL); w[0] = x.x; w[1] = x.y; }
}
constexpr int NTW = 4;
constexpr int NENT = NTW * NSEL;
constexpr int ENTR = NENT / 64;
static_assert(RB == 2 * NTW && NENT % 64 == 0 && NSEL % 16 == 0 && NSEL % 4 == 0 && (T % NTW) == 0, "gather group shape");
DEVFN int bucket_of(int e) {
  constexpr int NB = NEXP >> GSH;
  const int i = e / NKEY, j = e % NKEY;
  return ((i * NB) / NKEY + (j * NB) / NKEY) % NB;
}
DEVFN int uni_i(int v) {
#ifndef HOST_EMU
  return __builtin_amdgcn_readfirstlane(v);
#else
  return v;
#endif
}
DEVFN float uni_f(float v) { return __builtin_bit_cast(float, uni_i(__builtin_bit_cast(int, v))); }
DEVFN float dot_row(const unsigned (&w)[EW], const f32x2 (&hx)[2 * EW]) {
  f32x2 a = {0.f, 0.f};
#pragma unroll
  for (int k = 0; k < EW; ++k) { a += unpack_fp8_lo(w[k]) * hx[2 * k]; a += unpack_fp8_hi(w[k]) * hx[2 * k + 1]; }
  return a.x + a.y;
}
DEVFN void pk_fma_acc(f32x2& acc, f32x2 val, float c) {
#ifndef HOST_EMU
  const unsigned long long cs = (unsigned long long)__builtin_bit_cast(unsigned, c);
  asm("v_pk_fma_f32 %0, %1, %2, %0 op_sel_hi:[1,0,1]" : "+v"(acc) : "v"(val), "s"(cs));
#else
  acc += val * c;
#endif
}
DEVFN void axpy_row(const unsigned (&w)[EW], float c, f32x2 (&acc)[2 * EW]) {
#pragma unroll
  for (int g = 0; g < U4W; ++g) {
    pk_fma_acc(acc[4 * g], unpack_fp4<0>(w[U4W + g]), c); pk_fma_acc(acc[4 * g + 1], unpack_fp4<1>(w[U4W + g]), c);
    pk_fma_acc(acc[4 * g + 2], unpack_fp4<2>(w[U4W + g]), c); pk_fma_acc(acc[4 * g + 3], unpack_fp4<3>(w[U4W + g]), c);
  }
}
template <bool ISU>
DEVFN void gather4_load(RowBatch& B, int s0, const int* srt, int lane, int jr, const unsigned char* __restrict__ tab, const float* __restrict__ su, const float* __restrict__ sv) {
#pragma unroll
  for (int j = 0; j < RB; ++j) {
    const int e = uni_i(srt[(j % NTW) * NSEL + s0 + j / NTW]);
    load_row(tab + (size_t)e * DM, lane, B.w[j]);
  }
}
DEVFN float gather4_u(const RowBatch& B, int s0, const int (&hq)[NTW][EW], float shl, const float* sgt, const float* sut, int lane, int jr) {
  float d[RB];
#pragma unroll
  for (int j = 0; j < RB; ++j) {
    int ah = 0, al = 0;
#pragma unroll
    for (int g = 0; g < U4W; ++g) { ah = sdot8((int)B.w[j][g], hq[j % NTW][g], ah); al = sdot8((int)B.w[j][g], hq[j % NTW][U4W + g], al); }
    d[j] = (float)(16 * ah + al);
  }
  float r4[4], r2[2];
#pragma unroll
  for (int i = 0; i < 4; ++i) { swap32(d[i], d[i + 4]); r4[i] = d[i] + d[i + 4]; }
#pragma unroll
  for (int i = 0; i < 2; ++i) { swap16(r4[i], r4[i + 2]); r2[i] = r4[i] + r4[i + 2]; }
  const float t0 = r2[0] + dpp_f<0x128>(r2[0]), t1 = r2[1] + dpp_f<0x128>(r2[1]);
  float r = (lane & 8) ? t1 : t0;
  r += dpp_f<0x141>(r); r += dpp_f<0xB1>(r); r += dpp_f<0x4E>(r);
  const int li = (jr % NTW) * NSEL + s0 + jr / NTW;
  return sgt[li] * gelu_f(sut[li] * shl * r);
}
DEVFN void gather4_v(const RowBatch& B, float cf, f32x2 (&acc)[NTW][2 * EW]) {
#pragma unroll
  for (int j = 0; j < RB; ++j) axpy_row(B.w[j], bcast_lane(cf, 32 * ((j >> 2) & 1) + 16 * ((j >> 1) & 1) + 8 * (j & 1)), acc[j % NTW]);
}
DEVFN void ph_gather4(float* hio, const float* __restrict__ gn, const int* __restrict__ idx, const float* __restrict__ gate,
                      const unsigned char* __restrict__ ut, const unsigned char* __restrict__ vt, const float* __restrict__ su, const float* __restrict__ sv,
                      bf16_t* __restrict__ hb, float* __restrict__ rinv_next, const float* __restrict__ gfinal, char* smem, const XcdBarrier& xb, int which) {
  const int lane = TIDX & 63;
  XcdPace pc = xcd_pace_init(xb, which);
  static_assert(UPM == 12 && NSEL / 2 >= 16, "stagger assumes a pacing interval of 16 batches");
  const int pstag = uni_i(TIDX >> 6) >= NWV / 2 ? 8 : 0;
  int* srt = (int*)(smem + uni_i(TIDX >> 6) * (4 * NENT * 4));
  float* sgt = (float*)(srt + NENT);
  float* coefl = (float*)(srt + 2 * NENT);
  float* sut = (float*)(srt + 3 * NENT);
  const int jr = ((lane >> 5) & 1) * 4 + ((lane >> 4) & 1) * 2 + ((lane >> 3) & 1);
  constexpr int NGRP = T / NTW;
  const int g_iters = (NGRP + gridDim.x * NWV - 1) / (gridDim.x * NWV);
  for (int g_it = 0; g_it < g_iters; ++g_it) {
    const int g_raw = (g_it * gridDim.x + blockIdx.x) * NWV + uni_i(TIDX >> 6);
    const bool g_act = g_raw < NGRP;
    const int t0 = (g_act ? g_raw : NGRP - 1) * NTW;
    int hq[NTW][EW];
    float ri[NTW], sh[NTW];
#pragma unroll
    for (int k = 0; k < NTW; ++k) {
      f32x4 hv[EW];
      float ss = 0.f;
#pragma unroll
      for (int q = 0; q < EW; ++q) { hv[q] = *(const f32x4*)(hio + (size_t)(t0 + k) * DM + lane * EPL + 4 * q); ss += hv[q].x * hv[q].x + hv[q].y * hv[q].y + hv[q].z * hv[q].z + hv[q].w * hv[q].w; }
      ss = wave_sum(ss);
      ri[k] = rsqrtf(ss * (1.0f / DM) + RMS_EPS);
      float mxh = 0.f;
#pragma unroll
      for (int q = 0; q < EW; ++q) {
        const f32x4 gv = *(const f32x4*)(gn + lane * EPL + 4 * q);
        hv[q] = f32x4{hv[q].x * ri[k] * gv.x, hv[q].y * ri[k] * gv.y, hv[q].z * ri[k] * gv.z, hv[q].w * ri[k] * gv.w};
        mxh = fmaxf(mxh, fmaxf(fmaxf(fabsf(hv[q].x), fabsf(hv[q].y)), fmaxf(fabsf(hv[q].z), fabsf(hv[q].w))));
      }
      mxh = row16_max(mxh);
      { float a = mxh, b = mxh; swap16(a, b); mxh = fmaxf(mxh, (threadIdx.x & 16) ? a : b); }
      mxh = fmaxf(fmaxf(mxh, partner32(mxh)), 1e-30f);
      sh[k] = mxh * (1.0f / 119.0f);
      const float qi = 119.0f / mxh;
#pragma unroll
      for (int g = 0; g < U4W; ++g) {
        const float e8[8] = {hv[2 * g].x, hv[2 * g].y, hv[2 * g].z, hv[2 * g].w, hv[2 * g + 1].x, hv[2 * g + 1].y, hv[2 * g + 1].z, hv[2 * g + 1].w};
        unsigned wh = 0u, wl = 0u;
#pragma unroll
        for (int i = 0; i < 8; ++i) {
          const int t = (int)rintf(e8[i] * qi);
          const int tl = ((t + 8) & 15) - 8, th = (t - tl) >> 4;
          wh |= ((unsigned)th & 15u) << (4 * i); wl |= ((unsigned)tl & 15u) << (4 * i);
        }
        hq[k][g] = (int)wh; hq[k][U4W + g] = (int)wl;
      }
    }
    const float shl = (jr % NTW) == 0 ? sh[0] : (jr % NTW) == 1 ? sh[1] : (jr % NTW) == 2 ? sh[2] : sh[3];
    {
      int ent[ENTR]; float gt[ENTR], sue[ENTR]; int pos[ENTR];
#pragma unroll
      for (int r = 0; r < ENTR; ++r) {
        const int e = r * 64 + lane, k = e / NSEL, sl = e % NSEL;
        const float rik = k == 0 ? ri[0] : k == 1 ? ri[1] : k == 2 ? ri[2] : ri[3];
        ent[r] = idx[(size_t)(t0 + k) * NSEL + sl];
        const float raw = gate[(size_t)(t0 + k) * NSEL + sl];
        const float ex = __expf(rik * (raw - row16_max(raw)));
        const f32x2 sc = *(const f32x2*)(su + 2 * ent[r]);
        gt[r] = ex / row16_sum(ex) * sc.y; pos[r] = 0;
        sue[r] = sc.x;
      }
#pragma unroll
      for (int k = 0; k < NTW; ++k) {
        constexpr int dummy = 0; (void)dummy;
        const int r_lo = (k * NSEL) / 64, r_hi = ((k + 1) * NSEL + 63) / 64;
        int base = k * NSEL;
        for (int v = 0; v < (NEXP >> GSH); ++v) {
#pragma unroll
          for (int r = 0; r < ENTR; ++r) {
            if (r < r_lo || r >= r_hi) continue;
            const bool mine = ((r * 64 + lane) / NSEL == k) && (bucket_of(ent[r]) == v);
            const unsigned long long m = wave_ballot(mine);
            pos[r] = mine ? base + mbcnt64(m, lane) : pos[r];
            base += __builtin_popcountll(m);
          }
        }
      }
      WAVE_SYNC();
#pragma unroll
      for (int r = 0; r < ENTR; ++r) { srt[pos[r]] = ent[r]; sgt[pos[r]] = gt[r]; sut[pos[r]] = sue[r]; }
      WAVE_SYNC();
    }
    constexpr int NBQ = NSEL / 2;
    static_assert(NBQ % 4 == 0, "ring of four batches");
    f32x2 acc[NTW][2 * EW];
#pragma unroll
    for (int k = 0; k < NTW; ++k)
#pragma unroll
      for (int q = 0; q < 2 * EW; ++q) acc[k][q] = f32x2{0.f, 0.f};
    RowBatch A, B, C, D;
    auto ld = [&](RowBatch& X, int q) { gather4_load<true>(X, 2 * q, srt, lane, jr, ut, su, sv); };
    auto up = [&](const RowBatch& X, int q) { return gather4_u(X, 2 * q, hq, shl, sgt, sut, lane, jr); };
    auto vp = [&](const RowBatch& X, float cf) { gather4_v(X, cf, acc); };
    float cA, cB, cC, cD;
    ld(A, 0); ld(B, 1); ld(C, 2);
    cA = up(A, 0);
    for (int q = 0; q < NBQ - 4; q += 4) {
      if (CFG_GPACE && (q & UPM) == pstag) xcd_pace(pc);
      ld(D, q + 3);
      cB = up(B, q + 1); vp(A, cA); ld(A, q + 4);
      cC = up(C, q + 2); vp(B, cB); ld(B, q + 5);
      cD = up(D, q + 3); vp(C, cC); ld(C, q + 6);
      cA = up(A, q + 4); vp(D, cD);
    }
    ld(D, NBQ - 1);
    cB = up(B, NBQ - 3); vp(A, cA);
    cC = up(C, NBQ - 2); vp(B, cB);
    cD = up(D, NBQ - 1); vp(C, cC);
    vp(D, cD);
#pragma unroll
    for (int k = 0; k < NTW; ++k) {
      const int t = t0 + k;
      float hn[EPL]; float ss = 0.f;
#pragma unroll
      for (int q = 0; q < EW; ++q) {
        const f32x4 hv = *(const f32x4*)(hio + (size_t)t * DM + lane * EPL + 4 * q);
        hn[4 * q] = hv.x + acc[k][2 * q].x; hn[4 * q + 1] = hv.y + acc[k][2 * q].y; hn[4 * q + 2] = hv.z + acc[k][2 * q + 1].x; hn[4 * q + 3] = hv.w + acc[k][2 * q + 1].y;
      }
#pragma unroll
      for (int i = 0; i < EPL; ++i) ss += hn[i] * hn[i];
      ss = wave_sum(ss);
      const float rn = rsqrtf(ss * (1.0f / DM) + RMS_EPS);
      if (!g_act) {
      } else if (gfinal) {
#pragma unroll
        for (int q = 0; q < EW; ++q) {
          const f32x4 gv = *(const f32x4*)(gfinal + lane * EPL + 4 * q);
          *(f32x4*)(hio + (size_t)t * DM + lane * EPL + 4 * q) = f32x4{hn[4 * q] * rn * gv.x, hn[4 * q + 1] * rn * gv.y, hn[4 * q + 2] * rn * gv.z, hn[4 * q + 3] * rn * gv.w};
        }
      } else {
#pragma unroll
        for (int q = 0; q < EW; ++q) {
          *(f32x4*)(hio + (size_t)t * DM + lane * EPL + 4 * q) = f32x4{hn[4 * q], hn[4 * q + 1], hn[4 * q + 2], hn[4 * q + 3]};
          *(u32x2*)(hb + (size_t)t * DM + lane * EPL + 4 * q) = u32x2{pack2(hn[4 * q], hn[4 * q + 1]), pack2(hn[4 * q + 2], hn[4 * q + 3])};
        }
        if (lane == 0) rinv_next[t] = rn;
      }
    }
  }
}

constexpr int GLDW = 128 + 8;
DEVFN void ph_gmlp(const Params& P, const float* __restrict__ rinv_v, char* smem) {
  bf16_t* sW = (bf16_t*)smem;
  bf16_t* sVT = sW + 128 * GLDW;
  const bf16_t* __restrict__ pb = P.pb; const float* __restrict__ vg = P.in[23]; const float* __restrict__ bs = P.in[25];
  constexpr int NITEM = (T / 128) * NH;
  const int iters = (NITEM + gridDim.x - 1) / gridDim.x;
  const int tid = TIDX, lane = tid & 63, wv = tid >> 6, half = lane >> 5;
  int h_lds = -1;
  for (int it = 0; it < iters; ++it) {
    const int item = it * gridDim.x + blockIdx.x;
    const bool act = item < NITEM;
    const int h = item % NH, tok0 = (item / NH) * 128;
    __syncthreads();
    if (act) {
      if (h != h_lds) {
        h_lds = h;
        for (int e = tid; e < 128 * 16; e += NT) {
          const int row = e >> 4, c8 = (e & 15) * 8;
          *(u32x4*)(sW + row * GLDW + c8) = *(const u32x4*)(P.wsb + ((size_t)h * 128 + row) * 128 + c8);
        }
      }
      for (int e = tid; e < 128 * 8; e += NT) {
        const int sidx = e >> 3, d0 = (e & 7) * 8;
        const u32x4 w = *(const u32x4*)(pb + (size_t)(tok0 + sidx) * ODD_IN + AW + h * 64 + d0);
        const float ri = rinv_v[tok0 + sidx];
        const unsigned ws4[4] = {w.x, w.y, w.z, w.w};
#pragma unroll
        for (int j = 0; j < 4; ++j) {
          sVT[(d0 + 2 * j) * GLDW + sidx] = f2bf(gelu_f(bflo(ws4[j])) * ri * vg[h * 64 + d0 + 2 * j]);
          sVT[(d0 + 2 * j + 1) * GLDW + sidx] = f2bf(gelu_f(bfhi(ws4[j])) * ri * vg[h * 64 + d0 + 2 * j + 1]);
        }
      }
    }
    __syncthreads();
    if (!act) continue;
    const int mt = wv >> 1, nt = wv & 1;
    f32x16 acc;
#pragma unroll
    for (int r = 0; r < 16; ++r) acc[r] = 0.f;
    for (int ks = 0; ks < 2 * (mt + 1); ++ks) {
      const bf16x8 fa = *(const bf16x8*)(sW + (mt * 32 + (lane & 31)) * GLDW + ks * 16 + 8 * half);
      const bf16x8 fb = *(const bf16x8*)(sVT + (nt * 32 + (lane & 31)) * GLDW + ks * 16 + 8 * half);
      acc = mfma32(fa, fb, acc);
    }
    const int d = nt * 32 + (lane & 31);
#pragma unroll
    for (int r = 0; r < 16; ++r) {
      const int t = mt * 32 + (r & 3) + 8 * (r >> 2) + 4 * half;
      const float y = acc[r] + bs[h * 128 + t];
      const float u = gelu_f(bf2f(pb[(size_t)(tok0 + t) * ODD_IN + h * 64 + d]));
      P.cb[(size_t)(tok0 + t) * DM + h * 64 + d] = f2bf(u * y);
    }
  }
}

constexpr float SB_EXIT = -40.0f;
constexpr int VLD = 40;
DEVFN void ph_sbattn(const Params& P, char* smem) {
  const int tid = TIDX, lane = tid & 63, wv = tid >> 6, half = lane >> 5, l31 = lane & 31;
  bf16_t* vtp = (bf16_t*)(smem + wv * (64 * VLD * 2));
  constexpr int NQB = SEQ / 32;
  const bf16_t* __restrict__ pb = P.pb;
  for (int item = blockIdx.x * NWV + wv; item < NB * NH * NQB; item += gridDim.x * NWV) {
    const int qb = item % NQB, h = (item / NQB) % NH, b = item / (NQB * NH);
    const size_t tokb = (size_t)b * SEQ;
    bf16x8 qf[4];
    {
      const bf16_t* qp = pb + (tokb + qb * 32 + l31) * ODD_IN + 2 * AW + h * 64 + 8 * half;
#pragma unroll
      for (int s = 0; s < 4; ++s) qf[s] = *(const bf16x8*)(qp + 16 * s);
    }
    f32x16 oacc[2];
#pragma unroll
    for (int n = 0; n < 2; ++n)
#pragma unroll
      for (int r = 0; r < 16; ++r) oacc[n][r] = 0.f;
    float R = 0.f;
    const int qpos = qb * 32 + l31;
    for (int kt = qb; kt >= 0; --kt) {
      bf16x8 kf[4];
      {
        const bf16_t* kp = pb + (tokb + kt * 32 + l31) * ODD_IN + 3 * AW + h * 64 + 8 * half;
#pragma unroll
        for (int s = 0; s < 4; ++s) kf[s] = *(const bf16x8*)(kp + 16 * s);
      }
      WAVE_SYNC();
#pragma unroll
      for (int i = 0; i < 4; ++i) {
        const int c = lane + 64 * i, key = c >> 3, d0 = (c & 7) * 8;
        const u32x4 w = *(const u32x4*)(pb + (tokb + kt * 32 + key) * ODD_IN + 4 * AW + h * 64 + d0);
        const int slot = (key & 16) + 8 * ((key >> 2) & 1) + 4 * ((key >> 3) & 1) + (key & 3);
        const unsigned ws4[4] = {w.x, w.y, w.z, w.w};
#pragma unroll
        for (int j = 0; j < 4; ++j) {
          vtp[(d0 + 2 * j) * VLD + slot] = (bf16_t)(ws4[j] & 0xffffu);
          vtp[(d0 + 2 * j + 1) * VLD + slot] = (bf16_t)(ws4[j] >> 16);
        }
      }
      WAVE_SYNC();
      f32x16 z;
#pragma unroll
      for (int r = 0; r < 16; ++r) z[r] = 0.f;
#pragma unroll
      for (int s = 0; s < 4; ++s) z = mfma32(kf[s], qf[s], z);
      float lp[16], la[16];
#pragma unroll
      for (int r = 0; r < 16; ++r) {
        const int kpos = kt * 32 + (r & 3) + 8 * (r >> 2) + 4 * half;
        const bool valid = kpos < qpos;
        const float zz = z[r] * 0.125f;
        const float sp = fmaxf(zz, 0.f) + __logf(1.0f + __expf(-fabsf(zz)));
        lp[r] = valid ? -sp : 0.f;
        la[r] = valid ? zz - sp : -1.0e30f;
      }
      float e[16], tot[4], pt[4];
#pragma unroll
      for (int c = 0; c < 4; ++c) {
        e[4 * c + 3] = 0.f; e[4 * c + 2] = lp[4 * c + 3]; e[4 * c + 1] = e[4 * c + 2] + lp[4 * c + 2]; e[4 * c] = e[4 * c + 1] + lp[4 * c + 1];
        tot[c] = e[4 * c] + lp[4 * c];
      }
#pragma unroll
      for (int c = 0; c < 4; ++c) pt[c] = partner32(tot[c]);
      float G[8];
      G[7] = 0.f;
#pragma unroll
      for (int g = 6; g >= 0; --g) {
        const int c = (g + 1) >> 1;
        const bool odd = (g + 1) & 1;
        const float tg = odd ? (half ? tot[c] : pt[c]) : (half ? pt[c] : tot[c]);
        G[g] = G[g + 1] + tg;
      }
      const float total = G[0] + (half ? pt[0] : tot[0]);
      float w[16];
#pragma unroll
      for (int r = 0; r < 16; ++r) {
        const int c = r >> 2;
        const float gown = half ? G[2 * c + 1] : G[2 * c];
        w[r] = __expf(la[r] + R + gown + e[r]);
      }
      R += total;
#pragma unroll
      for (int s = 0; s < 2; ++s) {
        bf16x8 fa;
#pragma unroll
        for (int j = 0; j < 8; ++j) fa[j] = (short)f2bf(w[8 * s + j]);
#pragma unroll
        for (int n = 0; n < 2; ++n) {
          const bf16x8 fb = *(const bf16x8*)(vtp + (n * 32 + l31) * VLD + 16 * s + 8 * half);
          oacc[n] = mfma32(fa, fb, oacc[n]);
        }
      }
      if (__all(R < SB_EXIT)) break;
    }
#pragma unroll
    for (int n = 0; n < 2; ++n)
#pragma unroll
      for (int r = 0; r < 16; ++r) {
        const int row = (r & 3) + 8 * (r >> 2) + 4 * half;
        P.cb[(tokb + qb * 32 + row) * DM + AW + h * 64 + n * 32 + l31] = f2bf(oacc[n][r]);
      }
  }
}

#ifdef HOST_EMU
int emu_stage = 0;
#define EMU_STOP(n) if (emu_stage == n) return
#else
#define EMU_STOP(n)
#endif
__global__ void __launch_bounds__(NT) fwd_megakernel(Params P) {
  DECL_SMEM(smem, SMEM_BYTES);
#ifdef HOST_EMU
  const XcdBarrier xb{0};
#endif
#ifndef HOST_EMU
  if (threadIdx.x == 0) *(u32x4*)(smem + SMEM_BYTES - 16) = u32x4{0u, 0u, 0u, 0u};
  __syncthreads();
  const XcdBarrier xb = xcd_barrier_post(P.bar, (volatile LAS unsigned*)(smem + SMEM_BYTES - 16));
#endif
  const float* x = P.in[0];
  ph_prep(P, smem);
  GRID_SYNC();
  GEMM_SCALE(P.hb, P.wt_in0, DM, EVEN_IN, P.rinv, P.pb);
  XSYNC();
  ph_s5_pass1(P);
  ph_conv(P);
  XSYNC();
  ph_s5_pass2(P);
  {
    const int tidx[4] = {19, 20, 31, 32};
#pragma unroll
    for (int i = 0; i < 4; ++i) { if ((i & 1) == 0) prep_tab_i4(P.in[tidx[i]], P.tabs[i], P.tscale[i]); else prep_tab_fp4(P.in[tidx[i]], P.tabs[i - 1], P.tscale[i - 1]); }
  }
  XSYNC();
  ph_s5_pass3(P, smem);
  XSYNC();
  GEMM_GLU(P.ya, P.wt_glu, AW, AW, P.ya, P.in[12], P.cb);
  XSYNC();
  GEMM_RES(P.cb, P.wt_out0, DM, DM, x, P.hout, P.hb);
  XSYNC();
  EMU_STOP(1);
  GEMM_SCALE(P.hb, P.wt_q0, DM, QN, (const float*)nullptr, P.pb);
  XSYNC();
  ph_topk(P.pb, P.keys[0], P.keys[1], P.idx, P.gate, smem);
  XSYNC();
  ph_gather4(P.hout, P.in[15], P.idx, P.gate, P.tabs[0], P.tabs[1], P.tscale[0], P.tscale[1], P.hb, P.rinv2, nullptr, smem, xb, 0);
  XSYNC();
  EMU_STOP(2);
  GEMM_SCALE(P.hb, P.wt_in1, DM, ODD_IN, P.rinv2, P.pb);
  XSYNC();
  rowstat_v(P.pb, P.rinv);
  XSYNC();
  ph_gmlp(P, P.rinv, smem);
  __syncthreads();
  __syncthreads();
  ph_sbattn(P, smem);
  XSYNC();
  GEMM_RES(P.cb, P.wt_out1, DM, DM, P.hout, P.hout, P.hb);
  XSYNC();
  EMU_STOP(3);
  GEMM_SCALE(P.hb, P.wt_q1, DM, QN, (const float*)nullptr, P.pb);
  XSYNC();
  ph_topk(P.pb, P.keys[2], P.keys[3], P.idx, P.gate, smem);
  XSYNC();
  ph_gather4(P.hout, P.in[27], P.idx, P.gate, P.tabs[2], P.tabs[3], P.tscale[2], P.tscale[3], P.hb, P.rinv2, P.in[33], smem, xb, 1);
}

static inline size_t align_up(size_t x) { return (x + 255) & ~(size_t)255; }

extern "C" void kernel_launch(void* const* d_in, const int* in_sizes, int n_in, void* d_out, int out_size, void* d_ws, size_t ws_size, hipStream_t stream) {
  (void)in_sizes; (void)n_in; (void)out_size; (void)ws_size;
  Params P{};
  for (int i = 0; i < 34; ++i) P.in[i] = (const float*)d_in[i];
  P.hout = (float*)d_out;
  char* ws = (char*)d_ws; size_t off = 0;
  auto carve = [&](size_t bytes) { char* p = ws + off; off = align_up(off + bytes); return p; };
  P.wt_in0 = (bf16_t*)carve((size_t)EVEN_IN * DM * 2);
  P.wt_glu = (bf16_t*)carve((size_t)AW * AW * 2);
  P.wt_out0 = (bf16_t*)carve((size_t)DM * DM * 2);
  P.wt_q0 = (bf16_t*)carve((size_t)QN * DM * 2);
  P.wt_in1 = (bf16_t*)carve((size_t)ODD_IN * DM * 2);
  P.wt_out1 = (bf16_t*)carve((size_t)DM * DM * 2);
  P.wt_q1 = (bf16_t*)carve((size_t)QN * DM * 2);
  for (int i = 0; i < 4; ++i) P.keys[i] = (bf16_t*)carve((size_t)PH * NKEY * 128 * 2);
  for (int i = 0; i < 4; ++i) P.tabs[i] = (unsigned char*)carve((size_t)NEXP * DM);
  for (int i = 0; i < 4; ++i) P.tscale[i] = (i & 1) ? nullptr : (float*)carve((size_t)NEXP * 8);
  P.hb = (bf16_t*)carve((size_t)T * DM * 2);
  P.pb = (bf16_t*)carve((size_t)T * ODD_IN * 2);
  P.cb = (bf16_t*)carve((size_t)T * DM * 2);
  P.idx = (int*)carve((size_t)T * NSEL * 4);
  P.gate = (float*)carve((size_t)T * NSEL * 4);
  if constexpr ((size_t)AW * 2 <= (size_t)NSEL * 8) P.ya = (bf16_t*)P.idx;
  else P.ya = (bf16_t*)carve((size_t)T * AW * 2);
  P.S = (float*)carve((size_t)NB * NCH * NG * 128 * 4);
  P.S2 = (float*)carve((size_t)NB * NCH * NG * 128 * 4);
  P.rinv = (float*)carve((size_t)T * 4);
  P.rinv2 = (float*)carve((size_t)T * 4);
  P.bar = (unsigned*)carve(XCD_BAR_WORDS * 4);
  P.wsb = (bf16_t*)carve((size_t)NH * 128 * 128 * 2);
  P.tb.ar = (float*)carve(NG * 64 * 4); P.tb.ai = (float*)carve(NG * 64 * 4); P.tb.aqr = (float*)carve(NG * 64 * 4); P.tb.aqi = (float*)carve(NG * 64 * 4);
  P.tb.a16r = (float*)carve(NG * 64 * 4); P.tb.a16i = (float*)carve(NG * 64 * 4);
  P.tb.bbT = (bf16_t*)carve((size_t)NG * 128 * 16 * 2); P.tb.cmP = (bf16_t*)carve((size_t)NG * 16 * CMK * 2);
#ifdef HOST_EMU
  if (off > ws_size) { fprintf(stderr, "ws too small: need %zu have %zu\n", off, ws_size); abort(); }
  emu::launch(dim3(getenv("EMU_GRID") ? atoi(getenv("EMU_GRID")) : 3), dim3(NT), [=]() { fwd_megakernel(P); }, true);
#else
  static int grid_blocks = 0;
  if (!grid_blocks) {
    int dev = 0, cus = 0, per_cu = 0;
    hipGetDevice(&dev);
    hipDeviceGetAttribute(&cus, hipDeviceAttributeMultiprocessorCount, dev);
    hipOccupancyMaxActiveBlocksPerMultiprocessor(&per_cu, fwd_megakernel, NT, 0);
    if (per_cu > 1) per_cu = 1;
    grid_blocks = cus * per_cu;
  }
  (void)hipMemsetAsync(P.bar, 0, XCD_BAR_WORDS * 4, stream);
  void* args[] = {&P};
  hipError_t e = hipLaunchCooperativeKernel((void*)fwd_megakernel, dim3(grid_blocks), dim3(NT), args, 0, stream);
  if (e != hipSuccess) fprintf(stderr, "cooperative launch failed: %s (grid %d)\n", hipGetErrorString(e), grid_blocks);
#endif
}
```
